# Optimizing an MI355X kernel written in HIP

```python
import jax
import jax.numpy as jnp
from jax import lax
import numpy as np

D_MODEL = 1024
BATCH = 8
SEQ = 2048
DEPTH = 4
DEC_BATCH = 128
DEC_SEQ = 4
PAST_LEN = 8192
PAGE_SIZE = 128

D_MIX = D_MODEL
HEAD_DIM = 64
W_A = D_MIX // 4
W_B = D_MIX // 4
W_C = D_MIX // 4
W_D = D_MIX - W_A - W_B - W_C
N_Q = W_A // HEAD_DIM
N_KV = N_Q // 2
GQA_G = N_Q // N_KV
WINDOW = 128
Q_BLOCK = 128
N_HG = W_B // HEAD_DIM
HG_K = HEAD_DIM
HG_V = HEAD_DIM
HG_CHUNK = 64
LB_FLOOR = 1e-30
CONV_W = 3
POOL_WINDOWS = (2, 4, 8, 16)
N_POOL = 4
POOL_GW = W_D // N_POOL
POOL_BUF = 15
N_MEM = 256
N_XH = 4
X_HD = 64
D_X = N_XH * X_HD
D_FF = ((8 * D_MODEL + 3 * 256 - 1) // (3 * 256)) * 256
ALPHA = (2 * DEPTH) ** 0.25
BETA = (8 * DEPTH) ** -0.25
LN_EPS = 1e-5
RMS_EPS = 1e-6
MASK_VALUE = -1e30
SPLIT_SIZES = (W_A, N_KV * HEAD_DIM, N_KV * HEAD_DIM, W_B, W_B, W_B, W_B, W_C, W_C, W_C, W_D)
D_IN = W_A + 2 * N_KV * HEAD_DIM + 4 * W_B + 3 * W_C + W_D

kernel_name = 'hybrid_parallel_heads_decode_step'


def split_points():
    pts, acc = [], 0
    for s in SPLIT_SIZES[:-1]:
        acc += s
        pts.append(acc)
    return pts


def layer_norm(x, g, b):
    xf = x.astype(jnp.float32)
    mu = xf.mean(-1, keepdims=True)
    var = jnp.square(xf - mu).mean(-1, keepdims=True)
    return ((xf - mu) * lax.rsqrt(var + LN_EPS) * g + b).astype(x.dtype)


def alibi_slopes():
    h = jnp.arange(N_Q, dtype=jnp.float32) + 1.0
    return jnp.exp2(-8.0 * h / N_Q).reshape(N_KV, GQA_G)


def sliding_window_attention(q, k, v, k_buf, v_buf, pos0, sink, slopes):
    B, T = q.shape[:2]
    k_ext = jnp.concatenate([k_buf.astype(k.dtype), k], axis=1)
    v_ext = jnp.concatenate([v_buf.astype(v.dtype), v], axis=1)
    qb_len = Q_BLOCK if T % Q_BLOCK == 0 else T
    nb = T // qb_len
    idx = (jnp.arange(nb) * qb_len)[:, None] + jnp.arange(qb_len + WINDOW)[None, :]
    kb = k_ext[:, idx]
    vb = v_ext[:, idx]
    qb = q.reshape(B, nb, qb_len, N_KV, GQA_G, HEAD_DIM)
    s = jnp.einsum('bnqkgd,bnskd->bnkgqs', qb, kb).astype(jnp.float32) * (HEAD_DIM ** -0.5)
    k_pos = pos0 - WINDOW + idx
    q_pos = pos0 + jnp.arange(T).reshape(nb, qb_len)
    rel = q_pos[:, :, None] - k_pos[:, None, :]
    valid = (rel >= 0) & (rel <= WINDOW) & (k_pos[:, None, :] >= 0)
    s = s - slopes[None, None, :, :, None, None] * rel[None, :, None, None].astype(jnp.float32)
    s = jnp.where(valid[None, :, None, None], s, MASK_VALUE)
    sk = sink.astype(jnp.float32).reshape(N_KV, GQA_G)[None, None, :, :, None]
    m = jnp.maximum(jnp.max(s, axis=-1), sk)
    p = jnp.exp(s - m[..., None])
    denom = p.sum(-1) + jnp.exp(sk - m)
    p = p / denom[..., None]
    o = jnp.einsum('bnkgqs,bnskd->bnqkgd', p.astype(v.dtype), vb).reshape(B, T, N_Q * HEAD_DIM)
    return o, k_ext[:, -WINDOW:], v_ext[:, -WINDOW:]


def hgrn_lower_bounds(lb_param):
    p = jax.nn.softmax(lb_param.astype(jnp.float32), axis=0)
    return jnp.cumsum(p, axis=0) - p[0:1]


def hgrn2(q, f_pre, i, g, s0, lb, norm_g):
    B, T, _ = q.shape
    f32 = jnp.float32
    qh = jax.nn.silu(q.astype(f32)).reshape(B, T, N_HG, HG_K)
    fp = f_pre.astype(f32).reshape(B, T, N_HG, HG_K)
    lbh = lb.astype(f32).reshape(N_HG, HG_K)
    log_f = jnp.logaddexp(jax.nn.log_sigmoid(fp), jnp.log(jnp.maximum(lbh, LB_FLOOR)) + jax.nn.log_sigmoid(-fp))
    kh = (1.0 - lbh) * jax.nn.sigmoid(-fp)
    vh = i.astype(f32).reshape(B, T, N_HG, HG_V)
    c = HG_CHUNK if T % HG_CHUNK == 0 else T
    nc = T // c

    def to_chunks(a):
        return a.reshape(B, nc, c, N_HG, a.shape[-1]).swapaxes(0, 1)

    tril = jnp.tril(jnp.ones((c, c), dtype=bool))[None, :, :, None, None]

    def step(S, inp):
        qc, kc, vc, lfc = inp
        cum = jnp.cumsum(lfc, axis=1)
        o = jnp.einsum('bthk,bhkv->bthv', qc * jnp.exp(cum), S)
        diff = cum[:, :, None] - cum[:, None, :]
        decay = jnp.where(tril, jnp.exp(jnp.where(tril, diff, 0.0)), 0.0)
        a = jnp.einsum('bthk,bshk,btshk->bhts', qc, kc, decay)
        o = o + jnp.einsum('bhts,bshv->bthv', a, vc)
        last = cum[:, -1]
        S = jnp.exp(last)[..., None] * S + jnp.einsum('bshk,bshv->bhkv', kc * jnp.exp(last[:, None] - cum), vc)
        return S, o

    S, o = lax.scan(step, s0.astype(f32), (to_chunks(qh), to_chunks(kh), to_chunks(vh), to_chunks(log_f)))
    o = o.swapaxes(0, 1).reshape(B, T, N_HG, HG_V)
    o = o * lax.rsqrt(jnp.mean(jnp.square(o), axis=-1, keepdims=True) + RMS_EPS) * norm_g.astype(f32).reshape(N_HG, HG_V)
    o = o.reshape(B, T, W_B) * jax.nn.silu(g.astype(f32))
    return o.astype(q.dtype), S.astype(s0.dtype)


def short_conv(b_gate, c_gate, h, buf, conv_w):
    T = h.shape[1]
    u = c_gate * h
    ext = jnp.concatenate([buf.astype(u.dtype), u], axis=1)
    y = ext[:, 0:T] * conv_w[0]
    for j in range(1, CONV_W):
        y = y + ext[:, j:j + T] * conv_w[j]
    return b_gate * y, ext[:, -(CONV_W - 1):]


def pool_mixer(v, buf, pos0, pool_w, pool_scale):
    B, T, _ = v.shape
    ext_raw = jnp.concatenate([buf.astype(v.dtype), v], axis=1)
    ext = ext_raw.astype(jnp.float32)
    cs = jnp.concatenate([jnp.zeros((B, 1, W_D), jnp.float32), jnp.cumsum(ext, axis=1)], axis=1)
    pos = pos0 + jnp.arange(T)
    outs = []
    for gi, w in enumerate(POOL_WINDOWS):
        lo, hi = gi * POOL_GW, (gi + 1) * POOL_GW
        win_sum = cs[:, POOL_BUF + 1:POOL_BUF + 1 + T, lo:hi] - cs[:, POOL_BUF + 1 - w:POOL_BUF + 1 - w + T, lo:hi]
        cnt = jnp.minimum(pos + 1, w).astype(jnp.float32)
        outs.append(win_sum / cnt[None, :, None])
    pooled = (jnp.concatenate(outs, axis=-1) - v.astype(jnp.float32)).reshape(B, T, N_POOL, POOL_GW)
    y = jnp.einsum('btgc,gcd->btgd', pooled, pool_w.astype(jnp.float32)).reshape(B, T, W_D) * pool_scale
    return y.astype(v.dtype), ext_raw[:, -POOL_BUF:]


def memory_attention(x, mem_k, mem_v, w_xq, w_xo):
    B, T, _ = x.shape
    q = (x @ w_xq).reshape(B, T, N_XH, X_HD)
    s = jnp.einsum('bthd,bmhd->bhtm', q, mem_k).astype(jnp.float32) * (X_HD ** -0.5)
    p = jax.nn.softmax(s, axis=-1)
    o = jnp.einsum('bhtm,bmhd->bthd', p.astype(mem_v.dtype), mem_v).reshape(B, T, D_X)
    return o @ w_xo


def decoder_layer(x, k_buf, v_buf, s_hgrn, conv_buf, pool_buf, mem_k, mem_v, pos0,
                  w_in, attn_sink, lb, hgrn_norm_g, conv_w, pool_w, pool_scale, w_o,
                  ln1_g, ln1_b, w_xq, w_xo, ln2_g, ln2_b, w_gate, w_up, w_down, ln3_g, ln3_b):
    B, T, _ = x.shape
    proj = x @ w_in
    a_q, a_k, a_v, b_q, b_f, b_i, b_g, c_b, c_c, c_h, d_v = jnp.split(proj, split_points(), axis=-1)
    o_a, k_new, v_new = sliding_window_attention(
        a_q.reshape(B, T, N_Q, HEAD_DIM), a_k.reshape(B, T, N_KV, HEAD_DIM), a_v.reshape(B, T, N_KV, HEAD_DIM),
        k_buf, v_buf, pos0, attn_sink, alibi_slopes())
    o_b, s_new = hgrn2(b_q, b_f, b_i, b_g, s_hgrn, lb, hgrn_norm_g)
    o_c, conv_new = short_conv(c_b, c_c, c_h, conv_buf, conv_w)
    o_d, pool_new = pool_mixer(d_v, pool_buf, pos0, pool_w, pool_scale)
    mix = jnp.concatenate([o_a, o_b, o_c, o_d], axis=-1) @ w_o
    x = layer_norm(ALPHA * x + mix, ln1_g, ln1_b)
    x = layer_norm(ALPHA * x + memory_attention(x, mem_k, mem_v, w_xq, w_xo), ln2_g, ln2_b)
    ffn = (jax.nn.silu(x @ w_gate) * (x @ w_up)) @ w_down
    x = layer_norm(ALPHA * x + ffn, ln3_g, ln3_b)
    return x, k_new, v_new, s_new, conv_new, pool_new


def setup_inputs(seed: int = 0) -> dict:
    key = jax.random.key(seed)
    ks = iter(jax.random.split(key, 64))
    f32 = jnp.float32

    def nrm(shape, scale=1.0):
        return jax.random.normal(next(ks), shape, f32) * scale

    def gain(shape):
        return 1.0 + nrm(shape, 0.05)

    return {
        'x_prompt': nrm((BATCH, SEQ, D_MODEL)),
        'x_sample': nrm((DEC_BATCH, DEC_SEQ, D_MODEL)),
        'cache_swa_k': nrm((DEPTH, DEC_BATCH, WINDOW, N_KV, HEAD_DIM)),
        'cache_swa_v': nrm((DEPTH, DEC_BATCH, WINDOW, N_KV, HEAD_DIM)),
        'state_hgrn': nrm((DEPTH, DEC_BATCH, N_HG, HG_K, HG_V), 0.5),
        'state_conv': nrm((DEPTH, DEC_BATCH, CONV_W - 1, W_C)),
        'state_pool': nrm((DEPTH, DEC_BATCH, POOL_BUF, W_D)),
        'cache_mem_k': nrm((DEPTH, DEC_BATCH, N_MEM, N_XH, X_HD)),
        'cache_mem_v': nrm((DEPTH, DEC_BATCH, N_MEM, N_XH, X_HD)),
        'mem_prompt': nrm((BATCH, N_MEM, D_MODEL)),
        'emb_ln_g': gain((D_MODEL,)),
        'emb_ln_b': nrm((D_MODEL,), 0.05),
        'w_in': nrm((DEPTH, D_MODEL, D_IN), D_MODEL ** -0.5),
        'attn_sink': nrm((DEPTH, N_Q), 0.5),
        'hgrn_lb': nrm((DEPTH, W_B), 0.5),
        'hgrn_norm_g': gain((DEPTH, W_B)),
        'conv_w': nrm((DEPTH, CONV_W, W_C), CONV_W ** -0.5),
        'pool_w': nrm((DEPTH, N_POOL, POOL_GW, POOL_GW), POOL_GW ** -0.5),
        'pool_scale': 1.0 + nrm((DEPTH, W_D), 0.1),
        'w_o': nrm((DEPTH, D_MIX, D_MODEL), BETA * D_MIX ** -0.5),
        'ln1_g': gain((DEPTH, D_MODEL)),
        'ln1_b': nrm((DEPTH, D_MODEL), 0.05),
        'w_xq': nrm((DEPTH, D_MODEL, D_X), D_MODEL ** -0.5),
        'w_xk': nrm((DEPTH, D_MODEL, D_X), D_MODEL ** -0.5),
        'w_xv': nrm((DEPTH, D_MODEL, D_X), D_MODEL ** -0.5),
        'w_xo': nrm((DEPTH, D_X, D_MODEL), BETA * D_X ** -0.5),
        'ln2_g': gain((DEPTH, D_MODEL)),
        'ln2_b': nrm((DEPTH, D_MODEL), 0.05),
        'w_gate': nrm((DEPTH, D_MODEL, D_FF), D_MODEL ** -0.5),
        'w_up': nrm((DEPTH, D_MODEL, D_FF), D_MODEL ** -0.5),
        'w_down': nrm((DEPTH, D_FF, D_MODEL), BETA * D_FF ** -0.5),
        'ln3_g': gain((DEPTH, D_MODEL)),
        'ln3_b': nrm((DEPTH, D_MODEL), 0.05),
    }


def reference(x_prompt, x_sample, cache_swa_k, cache_swa_v, state_hgrn, state_conv, state_pool,
              cache_mem_k, cache_mem_v, mem_prompt, emb_ln_g, emb_ln_b, w_in, attn_sink, hgrn_lb,
              hgrn_norm_g, conv_w, pool_w, pool_scale, w_o, ln1_g, ln1_b, w_xq, w_xk, w_xv, w_xo,
              ln2_g, ln2_b, w_gate, w_up, w_down, ln3_g, ln3_b):
    lb_all = hgrn_lower_bounds(hgrn_lb)
    hp = layer_norm(x_prompt, emb_ln_g, emb_ln_b)
    hs = layer_norm(x_sample, emb_ln_g, emb_ln_b)
    bp = x_prompt.shape[0]
    dt = x_prompt.dtype
    z_kv = jnp.zeros((bp, WINDOW, N_KV, HEAD_DIM), dt)
    z_s = jnp.zeros((bp, N_HG, HG_K, HG_V), jnp.float32)
    z_c = jnp.zeros((bp, CONV_W - 1, W_C), dt)
    z_p = jnp.zeros((bp, POOL_BUF, W_D), dt)
    pk, pv, ps, pc, pp, pmk, pmv = [], [], [], [], [], [], []
    sk, sv, ss, sc, sp = [], [], [], [], []
    for l in range(DEPTH):
        mk = (mem_prompt @ w_xk[l]).reshape(bp, N_MEM, N_XH, X_HD)
        mv = (mem_prompt @ w_xv[l]).reshape(bp, N_MEM, N_XH, X_HD)
        lw = (w_in[l], attn_sink[l], lb_all[l], hgrn_norm_g[l], conv_w[l], pool_w[l], pool_scale[l], w_o[l],
              ln1_g[l], ln1_b[l], w_xq[l], w_xo[l], ln2_g[l], ln2_b[l], w_gate[l], w_up[l], w_down[l],
              ln3_g[l], ln3_b[l])
        hp, k1, v1, s1, c1, p1 = decoder_layer(hp, z_kv, z_kv, z_s, z_c, z_p, mk, mv, 0, *lw)
        hs, k2, v2, s2, c2, p2 = decoder_layer(hs, cache_swa_k[l], cache_swa_v[l], state_hgrn[l], state_conv[l],
                                               state_pool[l], cache_mem_k[l], cache_mem_v[l], PAST_LEN, *lw)
        pk.append(k1); pv.append(v1); ps.append(s1); pc.append(c1); pp.append(p1); pmk.append(mk); pmv.append(mv)
        sk.append(k2); sv.append(v2); ss.append(s2); sc.append(c2); sp.append(p2)
    return (hp, hs,
            jnp.stack(pk), jnp.stack(pv), jnp.stack(ps), jnp.stack(pc), jnp.stack(pp), jnp.stack(pmk), jnp.stack(pmv),
            jnp.stack(sk), jnp.stack(sv), jnp.stack(ss), jnp.stack(sc), jnp.stack(sp))
```

```cpp
#include <hip/hip_runtime.h>
#include <hip/hip_cooperative_groups.h>
#include <cstdio>
#include <cstdint>
namespace cg = cooperative_groups;

#ifndef MEGA
#define MEGA 1
#endif

typedef unsigned short u16;
using bf16x8 = __attribute__((ext_vector_type(8))) short;
using f32x4 = __attribute__((ext_vector_type(4))) float;
using u32x4 = __attribute__((ext_vector_type(4))) unsigned;
using u32x2 = __attribute__((ext_vector_type(2))) unsigned;
#define DEVI __device__ __forceinline__
#define LAS __attribute__((address_space(3)))

constexpr int T_P = 16384, T_S = 512, T_ALL = 16896;
constexpr int DM = 1024, DIN = 2560, DFF = 2816;
constexpr float ALPHA = 1.681792830507429f;
constexpr int C_AQ = 0, C_AK = 256, C_AV = 384, C_BQ = 512, C_BF = 768, C_BI = 1024, C_BG = 1280, C_CB = 1536, C_CC = 1792, C_CH = 2048, C_DV = 2304;
constexpr size_t O_Y = 0, O_SWAK_P = 17301504, O_SWAV_P = 17825792, O_HGRN_P = 18350080, O_CONV_P = 18874368, O_POOL_P = 18890752,
                 O_MEMK_P = 19013632, O_MEMV_P = 21110784, O_SWAK_S = 23207936, O_SWAV_S = 31596544, O_HGRN_S = 39985152,
                 O_CONV_S = 48373760, O_POOL_S = 48635904, O_TOTAL = 50601984;
constexpr size_t WS_XF = 0;
constexpr size_t WS_XB = WS_XF + (size_t)T_ALL * 1024 * 4;
constexpr size_t WS_PROJ = WS_XB + (size_t)T_ALL * 1024 * 2;
constexpr size_t WS_MIX = WS_PROJ + (size_t)T_ALL * 2560 * 2;
constexpr size_t WS_POOLED = WS_MIX + (size_t)T_ALL * 1024 * 2;
constexpr size_t WS_QX = WS_POOLED + (size_t)T_ALL * 256 * 2;
constexpr size_t WS_OX = WS_QX + (size_t)T_ALL * 256 * 2;
constexpr size_t WS_H = WS_OX + (size_t)T_ALL * 256 * 2;
constexpr size_t WS_WIN = WS_H + (size_t)T_ALL * 2816 * 2;
constexpr size_t WS_WO = WS_WIN + (size_t)4 * 2560 * 1024 * 2;
constexpr size_t WS_WXQ = WS_WO + (size_t)4 * 1024 * 1024 * 2;
constexpr size_t WS_WKV = WS_WXQ + (size_t)4 * 256 * 1024 * 2;
constexpr size_t WS_WXO = WS_WKV + (size_t)2048 * 1024 * 2;
constexpr size_t WS_WGU = WS_WXO + (size_t)4 * 1024 * 256 * 2;
constexpr size_t WS_WDN = WS_WGU + (size_t)4 * 5632 * 1024 * 2;
constexpr size_t WS_POOLT = WS_WDN + (size_t)4 * 1024 * 2816 * 2;
constexpr size_t WS_MEMP = WS_POOLT + (size_t)4 * 256 * 256 * 2;
constexpr size_t WS_MEMKV = WS_MEMP + (size_t)2048 * 1024 * 2;
constexpr size_t WS_HU = WS_MEMKV + (size_t)8 * 2048 * 256 * 2;
constexpr size_t WS_HD = WS_HU + (size_t)8 * 32 * 4 * 4096 * 4;
constexpr size_t WS_HS = WS_HD + (size_t)8 * 32 * 4 * 64 * 4;
constexpr size_t WS_SLAB = WS_HS + (size_t)8 * 32 * 4 * 4096 * 4;
constexpr size_t WS_BAR = WS_SLAB + (size_t)11 * 512 * 1024 * 4;
constexpr size_t WS_TOTAL = WS_BAR + 16384;

constexpr int SMEM_BYTES = 73728;

struct Params {
  const float *x_prompt, *x_sample, *cache_swa_k, *cache_swa_v, *state_hgrn, *state_conv, *state_pool, *cache_mem_k, *cache_mem_v,
      *mem_prompt, *emb_ln_g, *emb_ln_b, *w_in, *attn_sink, *hgrn_lb, *hgrn_norm_g, *conv_w, *pool_w, *pool_scale, *w_o, *ln1_g, *ln1_b,
      *w_xq, *w_xk, *w_xv, *w_xo, *ln2_g, *ln2_b, *w_gate, *w_up, *w_down, *ln3_g, *ln3_b;
  float* out;
  char* ws;
};

DEVI int tidx() { int t = threadIdx.x; asm volatile("" : "+v"(t)); return t; }
typedef float f32x2_t __attribute__((ext_vector_type(2)));
typedef __bf16 bf16x2_t __attribute__((ext_vector_type(2)));
DEVI u16 f2b(float f) { return __builtin_bit_cast(u16, (__bf16)f); }
DEVI float b2f(u16 h) { return __uint_as_float(((unsigned)h) << 16); }
DEVI unsigned pack2(float a, float b) { return __builtin_bit_cast(unsigned, __builtin_convertvector((f32x2_t){a, b}, bf16x2_t)); }
DEVI float blo(unsigned u) { return __uint_as_float(u << 16); }
DEVI float bhi(unsigned u) { return __uint_as_float(u & 0xffff0000u); }
DEVI f32x4 ldnt4(const float* p_) { return __builtin_nontemporal_load((const f32x4*)p_); }
DEVI float ldnt1(const float* p_) { return __builtin_nontemporal_load(p_); }
DEVI void stnt4(float* p_, f32x4 v) { __builtin_nontemporal_store(v, (f32x4*)p_); }
DEVI float wsum(float v) {
#pragma unroll
  for (int o = 32; o > 0; o >>= 1) v += __shfl_xor(v, o);
  return v;
}
DEVI float wmaxf(float v) {
#pragma unroll
  for (int o = 32; o > 0; o >>= 1) v = fmaxf(v, __shfl_xor(v, o));
  return v;
}
DEVI float sigmoidf_(float x) { return __builtin_amdgcn_rcpf(1.f + __expf(-x)); }
DEVI float siluf_(float x) { return x * __builtin_amdgcn_rcpf(1.f + __expf(-x)); }
DEVI void unpack8(uint4 u, float* f) {
  f[0] = blo(u.x); f[1] = bhi(u.x); f[2] = blo(u.y); f[3] = bhi(u.y);
  f[4] = blo(u.z); f[5] = bhi(u.z); f[6] = blo(u.w); f[7] = bhi(u.w);
}

DEVI void ln_phase(const Params& p, int mode, const float* __restrict__ g, const float* __restrict__ b, int kparts = 0) {
  const int lane = tidx() & 63, w = tidx() >> 6;
  float* xf = (float*)(p.ws + WS_XF);
  u16* xb = (u16*)(p.ws + WS_XB);
  float4 gg[4], bb[4];
#pragma unroll
  for (int i = 0; i < 4; i++) { gg[i] = ((const float4*)g)[lane + 64 * i]; bb[i] = ((const float4*)b)[lane + 64 * i]; }
  const int rstep = gridDim.x * 4;
  int r = blockIdx.x * 4 + w;
  float4 v[4], vn[4];
  if (r < T_ALL) {
    const float* src = (mode == 0) ? (r < T_P ? p.x_prompt + (size_t)r * 1024 : p.x_sample + (size_t)(r - T_P) * 1024) : xf + (size_t)r * 1024;
#pragma unroll
    for (int i = 0; i < 4; i++) { if (mode == 0) { const f32x4 t4 = ldnt4(src + (size_t)(lane + 64 * i) * 4); v[i] = make_float4(t4[0], t4[1], t4[2], t4[3]); } else v[i] = ((const float4*)src)[lane + 64 * i]; }
  }
  for (; r < T_ALL; r += rstep) {
    const int rn = r + rstep;
    if (rn < T_ALL) {
      const float* srcn = (mode == 0) ? (rn < T_P ? p.x_prompt + (size_t)rn * 1024 : p.x_sample + (size_t)(rn - T_P) * 1024) : xf + (size_t)rn * 1024;
#pragma unroll
      for (int i = 0; i < 4; i++) { if (mode == 0) { const f32x4 t4 = ldnt4(srcn + (size_t)(lane + 64 * i) * 4); vn[i] = make_float4(t4[0], t4[1], t4[2], t4[3]); } else vn[i] = ((const float4*)srcn)[lane + 64 * i]; }
    }
    if (mode != 0 && r >= T_P) {
#pragma unroll
      for (int i = 0; i < 4; i++) v[i] = make_float4(0.f, 0.f, 0.f, 0.f);
      for (int qk = 0; qk < kparts; qk++) {
        const float4* sl = (const float4*)((const float*)(p.ws + WS_SLAB) + ((size_t)qk * 512 + (r - T_P)) * 1024);
#pragma unroll
        for (int i = 0; i < 4; i++) { const float4 t4 = sl[lane + 64 * i]; v[i].x += t4.x; v[i].y += t4.y; v[i].z += t4.z; v[i].w += t4.w; }
      }
    }
    float s = 0.f, q = 0.f;
#pragma unroll
    for (int i = 0; i < 4; i++) {
      s += v[i].x + v[i].y + v[i].z + v[i].w;
      q += v[i].x * v[i].x + v[i].y * v[i].y + v[i].z * v[i].z + v[i].w * v[i].w;
    }
#pragma unroll
    for (int o = 32; o > 0; o >>= 1) { const float s2 = __shfl_xor(s, o), q2 = __shfl_xor(q, o); s += s2; q += q2; }
    const float mu = s * (1.f / 1024.f);
    const float var = fmaxf(q * (1.f / 1024.f) - mu * mu, 0.f);
    const float rs = rsqrtf(var + 1e-5f);
#pragma unroll
    for (int i = 0; i < 4; i++) {
      float4 o;
      o.x = (v[i].x - mu) * rs * gg[i].x + bb[i].x; o.y = (v[i].y - mu) * rs * gg[i].y + bb[i].y;
      o.z = (v[i].z - mu) * rs * gg[i].z + bb[i].z; o.w = (v[i].w - mu) * rs * gg[i].w + bb[i].w;
      uint2 pk; pk.x = pack2(o.x, o.y); pk.y = pack2(o.z, o.w);
      if (mode != 2) ((uint2*)(xb + (size_t)r * 1024))[lane + 64 * i] = pk;
      if (mode == 2) stnt4(p.out + O_Y + (size_t)r * 1024 + (size_t)(lane + 64 * i) * 4, (f32x4){o.x, o.y, o.z, o.w});
    }
#pragma unroll
    for (int i = 0; i < 4; i++) v[i] = vn[i];
  }
}

DEVI void transpose_tile(const float* __restrict__ src, int N, int k0, int n0, u16* __restrict__ dst, int ldd, int mode, char* smem) {
  float* tile = (float*)smem;
  const int tid = tidx();
#pragma unroll
  for (int i = 0; i < 16; i++) {
    int idx = tid + i * 256; int kr = idx >> 6, nc = idx & 63;
    tile[kr * 65 + nc] = src[(size_t)(k0 + kr) * N + n0 + nc];
  }
  __syncthreads();
#pragma unroll
  for (int i = 0; i < 2; i++) {
    int idx = tid + i * 256; int nr = idx >> 3, kc = (idx & 7) * 8;
    int n = n0 + nr;
    int drow = (mode == 0) ? n : ((n >> 5) * 64 + (n & 31) + (mode == 2 ? 32 : 0));
    uint4 o;
    o.x = pack2(tile[(kc + 0) * 65 + nr], tile[(kc + 1) * 65 + nr]);
    o.y = pack2(tile[(kc + 2) * 65 + nr], tile[(kc + 3) * 65 + nr]);
    o.z = pack2(tile[(kc + 4) * 65 + nr], tile[(kc + 5) * 65 + nr]);
    o.w = pack2(tile[(kc + 6) * 65 + nr], tile[(kc + 7) * 65 + nr]);
    *(uint4*)(dst + (size_t)drow * ldd + k0 + kc) = o;
  }
  __syncthreads();
}

struct TJob { const float* src; u16* dst; int K, N, mode, k0, n0; };
constexpr int TR_PER_L = 3264;
DEVI TJob decode_tjob(const Params& p, int t) {
  TJob j;
  const int l = t / TR_PER_L; int tt = t % TR_PER_L;
  j.mode = 0;
  if (tt < 640) { j.src = p.w_in + (size_t)l * 1024 * 2560; j.K = 1024; j.N = 2560; j.dst = (u16*)(p.ws + WS_WIN) + (size_t)l * 2560 * 1024; }
  else if ((tt -= 640) < 256) { j.src = p.w_o + (size_t)l * 1024 * 1024; j.K = 1024; j.N = 1024; j.dst = (u16*)(p.ws + WS_WO) + (size_t)l * 1024 * 1024; }
  else if ((tt -= 256) < 64) { j.src = p.w_xq + (size_t)l * 1024 * 256; j.K = 1024; j.N = 256; j.dst = (u16*)(p.ws + WS_WXQ) + (size_t)l * 256 * 1024; }
  else if ((tt -= 64) < 64) { j.src = p.w_xk + (size_t)l * 1024 * 256; j.K = 1024; j.N = 256; j.dst = (u16*)(p.ws + WS_WKV) + (size_t)l * 256 * 1024; }
  else if ((tt -= 64) < 64) { j.src = p.w_xv + (size_t)l * 1024 * 256; j.K = 1024; j.N = 256; j.dst = (u16*)(p.ws + WS_WKV) + (size_t)(4 + l) * 256 * 1024; }
  else if ((tt -= 64) < 64) { j.src = p.w_xo + (size_t)l * 256 * 1024; j.K = 256; j.N = 1024; j.dst = (u16*)(p.ws + WS_WXO) + (size_t)l * 1024 * 256; }
  else if ((tt -= 64) < 704) { j.src = p.w_gate + (size_t)l * 1024 * 2816; j.K = 1024; j.N = 2816; j.dst = (u16*)(p.ws + WS_WGU) + (size_t)l * 5632 * 1024; j.mode = 1; }
  else if ((tt -= 704) < 704) { j.src = p.w_up + (size_t)l * 1024 * 2816; j.K = 1024; j.N = 2816; j.dst = (u16*)(p.ws + WS_WGU) + (size_t)l * 5632 * 1024; j.mode = 2; }
  else { tt -= 704; j.src = p.w_down + (size_t)l * 2816 * 1024; j.K = 2816; j.N = 1024; j.dst = (u16*)(p.ws + WS_WDN) + (size_t)l * 1024 * 2816; }
  const int nkt = j.K >> 6;
  j.k0 = (tt % nkt) * 64; j.n0 = (tt / nkt) * 64;
  return j;
}

DEVI void prologue_phase(const Params& p, char* smem) {
  ln_phase(p, 0, p.emb_ln_g, p.emb_ln_b);
  {
    const int tid = tidx();
    float* tile = (float*)smem;
    const int total = 4 * TR_PER_L;
    int t = blockIdx.x;
    float rc[16], rn[16];
    TJob jc{}, jn{};
    if (t < total) { jc = decode_tjob(p, t);
#pragma unroll
      for (int i = 0; i < 16; i++) { int idx = tid + i * 256; rc[i] = ldnt1(jc.src + (size_t)(jc.k0 + (idx >> 6)) * jc.N + jc.n0 + (idx & 63)); } }
    for (; t < total; t += gridDim.x) {
      const int tn = t + gridDim.x;
      if (tn < total) { jn = decode_tjob(p, tn);
#pragma unroll
        for (int i = 0; i < 16; i++) { int idx = tid + i * 256; rn[i] = ldnt1(jn.src + (size_t)(jn.k0 + (idx >> 6)) * jn.N + jn.n0 + (idx & 63)); } }
#pragma unroll
      for (int i = 0; i < 16; i++) { int idx = tid + i * 256; tile[(idx >> 6) * 65 + (idx & 63)] = rc[i]; }
      __syncthreads();
#pragma unroll
      for (int i = 0; i < 2; i++) {
        int idx = tid + i * 256; int nr = idx >> 3, kc = (idx & 7) * 8;
        int n = jc.n0 + nr;
        int drow = (jc.mode == 0) ? n : ((n >> 5) * 64 + (n & 31) + (jc.mode == 2 ? 32 : 0));
        uint4 o;
        o.x = pack2(tile[(kc + 0) * 65 + nr], tile[(kc + 1) * 65 + nr]);
        o.y = pack2(tile[(kc + 2) * 65 + nr], tile[(kc + 3) * 65 + nr]);
        o.z = pack2(tile[(kc + 4) * 65 + nr], tile[(kc + 5) * 65 + nr]);
        o.w = pack2(tile[(kc + 6) * 65 + nr], tile[(kc + 7) * 65 + nr]);
        *(uint4*)(jc.dst + (size_t)drow * jc.K + jc.k0 + kc) = o;
      }
      __syncthreads();
      jc = jn;
#pragma unroll
      for (int i = 0; i < 16; i++) rc[i] = rn[i];
    }
  }
  const int gtid = blockIdx.x * 256 + tidx(), gsz = gridDim.x * 256;
  {
    u16* pt = (u16*)(p.ws + WS_POOLT);
    for (int e = gtid; e < 4 * 256 * 256; e += gsz) {
      int l = e >> 16, n = (e >> 8) & 255, k = e & 255;
      int g = n >> 6, d = n & 63, g2 = k >> 6, c = k & 63;
      float v = (g == g2) ? p.pool_w[(((size_t)l * 4 + g) * 64 + c) * 64 + d] : 0.f;
      pt[e] = f2b(v);
    }
  }
  {
    u16* mp = (u16*)(p.ws + WS_MEMP);
    for (int e = gtid; e < 2048 * 1024 / 4; e += gsz) {
      float4 v = ((const float4*)p.mem_prompt)[e];
      uint2 pk; pk.x = pack2(v.x, v.y); pk.y = pack2(v.z, v.w);
      ((uint2*)mp)[e] = pk;
    }
  }
  {
    const int per = 4 * 128 * 124 * 32;
    for (int e0 = gtid; e0 < 2 * per; e0 += 4 * gsz) {
      float4 v[4];
      size_t doff[4];
      int whichv[4];
#pragma unroll
      for (int u = 0; u < 4; u++) {
        const int e = e0 + u * gsz;
        v[u] = make_float4(0, 0, 0, 0); doff[u] = 0; whichv[u] = -1;
        if (e < 2 * per) {
          int which = e / per, r = e % per;
          int c4 = r & 31; int i = (r >> 5) % 124; int ls = (r >> 5) / 124;
          const float* src = which ? p.cache_swa_v : p.cache_swa_k;
          { const f32x4 t4 = ldnt4(src + ((size_t)ls * 128 + i + 4) * 128 + c4 * 4); v[u] = make_float4(t4[0], t4[1], t4[2], t4[3]); }
          doff[u] = ((size_t)ls * 128 + i) * 128 + c4 * 4;
          whichv[u] = which;
        }
      }
#pragma unroll
      for (int u = 0; u < 4; u++)
        if (whichv[u] >= 0) stnt4(p.out + (whichv[u] ? O_SWAV_S : O_SWAK_S) + doff[u], (f32x4){v[u].x, v[u].y, v[u].z, v[u].w});
    }
  }
}

enum { EPI_BF16 = 0, EPI_RESID = 1, EPI_SWIGLU = 2, EPI_MEMKV = 3, EPI_POOL = 4, EPI_RESID_ATOMIC = 5 };

DEVI void dma16(const void* g, unsigned lds) {
  unsigned keep;
  asm volatile("s_mov_b32 %0, m0\n\ts_mov_b32 m0, %2\n\ts_nop 0\n\tglobal_load_lds_dwordx4 %1, off\n\ts_mov_b32 m0, %0"
               : "=&s"(keep) : "v"(g), "s"(lds) : "memory");
}

template <int EPI>
DEVI void gemm_tile(const Params& p, const u16* __restrict__ A, int lda, const u16* __restrict__ Bt, int K, int m0, int n0,
                          int l, u16* __restrict__ outb, int ldc, char* smem, int kbeg = 0, int nk_part = -1, bool first = true) {
  const int tid = tidx(), lane = tid & 63, wid = tid >> 6;
  const int wm = wid >> 1, wn = wid & 1, r16 = lane & 15, quad = lane >> 4;
  f32x4 acc[4][4];
#pragma unroll
  for (int i = 0; i < 4; i++)
#pragma unroll
    for (int j = 0; j < 4; j++) acc[i][j] = (f32x4){0.f, 0.f, 0.f, 0.f};
  const int nk = (nk_part < 0) ? (K >> 5) : nk_part;
  const int lrow = tid >> 2, lpc = tid & 3;
  const int lch = lpc ^ ((0x78 >> (((lrow >> 2) & 3) * 2)) & 3);
  const u16* ga = A + (size_t)(m0 + lrow) * lda + kbeg + lch * 8;
  const u16* gb = Bt + (size_t)(n0 + lrow) * K + kbeg + lch * 8;
  const size_t ga1 = (size_t)64 * lda, gb1 = (size_t)64 * K;
  const unsigned lds0 = (unsigned)(uintptr_t)(LAS char*)smem + (unsigned)__builtin_amdgcn_readfirstlane(wid) * 1024u;
#define GEMM_STAGE(kt_)                                                             \
  do {                                                                              \
    const unsigned sb_ = lds0 + (unsigned)((kt_) & 3) * 16384u;                     \
    const u16* a_ = ga + (size_t)(kt_) * 32;                                        \
    const u16* b_ = gb + (size_t)(kt_) * 32;                                        \
    dma16(a_, sb_); dma16(a_ + ga1, sb_ + 4096u);                                   \
    dma16(b_, sb_ + 8192u); dma16(b_ + gb1, sb_ + 12288u);                          \
  } while (0)
  __syncthreads();
  GEMM_STAGE(0); GEMM_STAGE(1); GEMM_STAGE(2); GEMM_STAGE(3);
  const int fsw = (0x78 >> (((r16 >> 2) & 3) * 2)) & 3;
  const int aoff = (wm * 64 + r16) * 64 + ((quad ^ fsw) << 4);
  const int boff = 8192 + (wn * 64 + r16) * 64 + ((quad ^ fsw) << 4);
  bf16x8 xa0[4], wb0[4], xa1[4], wb1[4];
#define GEMM_READ(kt_, XA, WB)                                   \
  do {                                                           \
    const char* cS_ = smem + ((kt_) & 3) * 16384;                \
    _Pragma("unroll") for (int f = 0; f < 4; f++) {              \
      XA[f] = *(const bf16x8*)(cS_ + aoff + f * 1024);           \
      WB[f] = *(const bf16x8*)(cS_ + boff + f * 1024);           \
    }                                                            \
  } while (0)
#define GEMM_MMA(XA, WB)                                                                              \
  do {                                                                                                \
    _Pragma("unroll") for (int nf = 0; nf < 4; nf++)                                                  \
      _Pragma("unroll") for (int mf = 0; mf < 4; mf++)                                                \
        acc[nf][mf] = __builtin_amdgcn_mfma_f32_16x16x32_bf16(WB[nf], XA[mf], acc[nf][mf], 0, 0, 0);  \
  } while (0)
#define GEMM_STEP(kt_, XAC, WBC, XAN, WBN)                                          \
  do {                                                                              \
    if ((kt_) + 3 < nk) asm volatile("s_waitcnt vmcnt(8)" ::: "memory");            \
    else if ((kt_) + 2 < nk) asm volatile("s_waitcnt vmcnt(4)" ::: "memory");       \
    else asm volatile("s_waitcnt vmcnt(0)" ::: "memory");                           \
    asm volatile("s_waitcnt lgkmcnt(0)" ::: "memory");                              \
    __builtin_amdgcn_s_barrier();                                                   \
    asm volatile("" ::: "memory");                                                  \
    if ((kt_) + 4 < nk) GEMM_STAGE((kt_) + 4);                                      \
    if ((kt_) + 1 < nk) GEMM_READ((kt_) + 1, XAN, WBN);                             \
    GEMM_MMA(XAC, WBC);                                                             \
  } while (0)
  asm volatile("s_waitcnt vmcnt(12)" ::: "memory");
  __builtin_amdgcn_s_barrier();
  asm volatile("" ::: "memory");
  GEMM_READ(0, xa0, wb0);
  for (int kt = 0; kt < nk; kt += 2) {
    GEMM_STEP(kt, xa0, wb0, xa1, wb1);
    GEMM_STEP(kt + 1, xa1, wb1, xa0, wb0);
  }
#undef GEMM_READ
#undef GEMM_MMA
#undef GEMM_STEP
#undef GEMM_STAGE
#pragma unroll
  for (int mf = 0; mf < 4; mf++) {
    const int row = m0 + wm * 64 + mf * 16 + r16;
    if (EPI == EPI_SWIGLU) {
#pragma unroll
      for (int nf = 0; nf < 2; nf++) {
        const int hcol = (n0 >> 1) + wn * 32 + nf * 16 + quad * 4;
        f32x4 g = acc[nf][mf], u = acc[nf + 2][mf];
        uint2 pk;
        pk.x = pack2(siluf_(g[0]) * u[0], siluf_(g[1]) * u[1]);
        pk.y = pack2(siluf_(g[2]) * u[2], siluf_(g[3]) * u[3]);
        *(uint2*)(outb + (size_t)row * DFF + hcol) = pk;
      }
    } else {
#pragma unroll
      for (int nf = 0; nf < 4; nf++) {
        const int col = n0 + wn * 64 + nf * 16 + quad * 4;
        f32x4 a = acc[nf][mf];
        if (EPI == EPI_BF16) {
          uint2 pk; pk.x = pack2(a[0], a[1]); pk.y = pack2(a[2], a[3]);
          *(uint2*)(outb + (size_t)row * ldc + col) = pk;
        } else if (EPI == EPI_RESID) {
          const u32x2 xr = *(const u32x2*)((const u16*)(p.ws + WS_XB) + (size_t)row * 1024 + col);
          f32x4 x;
          x[0] = ALPHA * blo(xr[0]) + a[0]; x[1] = ALPHA * bhi(xr[0]) + a[1]; x[2] = ALPHA * blo(xr[1]) + a[2]; x[3] = ALPHA * bhi(xr[1]) + a[3];
          *(f32x4*)((float*)(p.ws + WS_XF) + (size_t)row * 1024 + col) = x;
        } else if (EPI == EPI_RESID_ATOMIC) {
          f32x4 x = a;
          if (first) {
            const u32x2 xr = *(const u32x2*)((const u16*)(p.ws + WS_XB) + (size_t)row * 1024 + col);
            x[0] += ALPHA * blo(xr[0]); x[1] += ALPHA * bhi(xr[0]); x[2] += ALPHA * blo(xr[1]); x[3] += ALPHA * bhi(xr[1]);
          }
          *(f32x4*)((float*)(p.ws + WS_SLAB) + ((size_t)l * 512 + (row - T_P)) * 1024 + col) = x;
        } else if (EPI == EPI_MEMKV) {
          const int which = col >> 10, ll = (col >> 8) & 3, c = col & 255;
          float* dst = p.out + (which ? O_MEMV_P : O_MEMK_P) + ((size_t)ll * 2048 + row) * 256 + c;
          *(float4*)dst = make_float4(a[0], a[1], a[2], a[3]);
          uint2 pk; pk.x = pack2(a[0], a[1]); pk.y = pack2(a[2], a[3]);
          *(uint2*)((u16*)(p.ws + WS_MEMKV) + ((size_t)(which * 4 + ll) * 2048 + row) * 256 + c) = pk;
        } else if (EPI == EPI_POOL) {
          const float4 sc = *(const float4*)(p.pool_scale + l * 256 + col);
          uint2 pk; pk.x = pack2(a[0] * sc.x, a[1] * sc.y); pk.y = pack2(a[2] * sc.z, a[3] * sc.w);
          *(uint2*)((u16*)(p.ws + WS_MIX) + (size_t)row * 1024 + 768 + col) = pk;
        }
      }
    }
  }
}


template <int EPI>
DEVI void gemm_tile256(const Params& p, const u16* __restrict__ A, int lda, const u16* __restrict__ Bt, int K, int m0, int n0,
                       u16* __restrict__ outb, int ldc, char* smem, int kbeg = 0, int nk_part = -1, int kpart = 0) {
  const int tid = tidx(), lane = tid & 63, wid = tid >> 6;
  const int wm = wid >> 1, wn = wid & 1, r16 = lane & 15, quad = lane >> 4;
  f32x4 acc[4][8];
#pragma unroll
  for (int i = 0; i < 4; i++)
#pragma unroll
    for (int j = 0; j < 8; j++) acc[i][j] = (f32x4){0.f, 0.f, 0.f, 0.f};
  const int nk = (nk_part < 0) ? (K >> 5) : nk_part;
  const int lrow = tid >> 2, lpc = tid & 3;
  const int lch = lpc ^ ((0x78 >> (((lrow >> 2) & 3) * 2)) & 3);
  const u16* ga = A + (size_t)(m0 + lrow) * lda + kbeg + lch * 8;
  const u16* gb = Bt + (size_t)(n0 + lrow) * K + kbeg + lch * 8;
  const size_t ga1 = (size_t)64 * lda, gb1 = (size_t)64 * K;
  const unsigned lds0 = (unsigned)(uintptr_t)(LAS char*)smem + (unsigned)__builtin_amdgcn_readfirstlane(wid) * 1024u;
#define G2_STAGE(kt_)                                                               \
  do {                                                                              \
    const unsigned sb_ = lds0 + (unsigned)((kt_) % 3) * 24576u;                     \
    const u16* a_ = ga + (size_t)(kt_) * 32;                                        \
    const u16* b_ = gb + (size_t)(kt_) * 32;                                        \
    dma16(a_, sb_); dma16(a_ + ga1, sb_ + 4096u);                                   \
    dma16(a_ + 2 * ga1, sb_ + 8192u); dma16(a_ + 3 * ga1, sb_ + 12288u);            \
    dma16(b_, sb_ + 16384u); dma16(b_ + gb1, sb_ + 20480u);                         \
  } while (0)
  __syncthreads();
  G2_STAGE(0); G2_STAGE(1);
  const int fsw = (0x78 >> (((r16 >> 2) & 3) * 2)) & 3;
  const int aoff = (wm * 128 + r16) * 64 + ((quad ^ fsw) << 4);
  const int boff = 16384 + (wn * 64 + r16) * 64 + ((quad ^ fsw) << 4);
  for (int kt = 0; kt < nk; kt++) {
    if (kt + 1 < nk) asm volatile("s_waitcnt vmcnt(6)" ::: "memory");
    else asm volatile("s_waitcnt vmcnt(0)" ::: "memory");
    __builtin_amdgcn_s_barrier();
    asm volatile("" ::: "memory");
    if (kt + 2 < nk) G2_STAGE(kt + 2);
    const char* cS = smem + (kt % 3) * 24576;
    bf16x8 xa[8], wb[4];
#pragma unroll
    for (int f = 0; f < 8; f++) xa[f] = *(const bf16x8*)(cS + aoff + f * 1024);
#pragma unroll
    for (int f = 0; f < 4; f++) wb[f] = *(const bf16x8*)(cS + boff + f * 1024);
#pragma unroll
    for (int nf = 0; nf < 4; nf++)
#pragma unroll
      for (int mf = 0; mf < 8; mf++)
        acc[nf][mf] = __builtin_amdgcn_mfma_f32_16x16x32_bf16(wb[nf], xa[mf], acc[nf][mf], 0, 0, 0);
  }
#undef G2_STAGE
#pragma unroll
  for (int mf = 0; mf < 8; mf++) {
    const int row = m0 + wm * 128 + mf * 16 + r16;
    if (EPI == EPI_SWIGLU) {
#pragma unroll
      for (int nf = 0; nf < 2; nf++) {
        const int hcol = (n0 >> 1) + wn * 32 + nf * 16 + quad * 4;
        f32x4 g = acc[nf][mf], u = acc[nf + 2][mf];
        u32x2 pk;
        pk[0] = pack2(siluf_(g[0]) * u[0], siluf_(g[1]) * u[1]);
        pk[1] = pack2(siluf_(g[2]) * u[2], siluf_(g[3]) * u[3]);
        *(u32x2*)(outb + (size_t)row * DFF + hcol) = pk;
      }
    } else {
#pragma unroll
      for (int nf = 0; nf < 4; nf++) {
        const int col = n0 + wn * 64 + nf * 16 + quad * 4;
        f32x4 a = acc[nf][mf];
        if (EPI == EPI_RESID || EPI == EPI_RESID_ATOMIC) {
          f32x4 x = a;
          if (EPI == EPI_RESID || kpart == 0) {
            const u32x2 xr = *(const u32x2*)((const u16*)(p.ws + WS_XB) + (size_t)row * 1024 + col);
            x[0] += ALPHA * blo(xr[0]); x[1] += ALPHA * bhi(xr[0]); x[2] += ALPHA * blo(xr[1]); x[3] += ALPHA * bhi(xr[1]);
          }
          if (EPI == EPI_RESID) *(f32x4*)((float*)(p.ws + WS_XF) + (size_t)row * 1024 + col) = x;
          else *(f32x4*)((float*)(p.ws + WS_SLAB) + ((size_t)kpart * 512 + (row - T_P)) * 1024 + col) = x;
        } else {
          u32x2 pk; pk[0] = pack2(a[0], a[1]); pk[1] = pack2(a[2], a[3]);
          *(u32x2*)(outb + (size_t)row * ldc + col) = pk;
        }
      }
    }
  }
}

DEVI void attn256_item(const u16* __restrict__ Kb, int kstride, const u16* __restrict__ Vb, int kvalid0,
                             const u16* __restrict__ Qb, int qstride, u16* __restrict__ Ob, int ostride,
                             int mode, float slope0, float slope1, float sink0, float sink1, char* smem, int it0 = 0, int it1 = 4) {
  const int tid = tidx(), lane = tid & 63, w = tid >> 6, r16 = lane & 15, quad = lane >> 4;
  char* sK = smem;
  u16* sVt = (u16*)(smem + 32768);
  const int gq = mode ? (w & 1) : 0;
  const int tbase = mode ? (w >> 1) * 64 : w * 64;
  bf16x8 qn[2];
  {
    const u16* qp0 = Qb + (size_t)(tbase + it0 * 16 + r16) * qstride + gq * 64;
    qn[0] = *(const bf16x8*)(qp0 + quad * 8);
    qn[1] = *(const bf16x8*)(qp0 + 32 + quad * 8);
  }
  __syncthreads();
  {
    uint4 kreg[8], vreg[8];
#pragma unroll
    for (int i = 0; i < 8; i++) {
      int idx = tid + i * 256; int key = idx >> 3, ch = idx & 7;
      kreg[i] = make_uint4(0, 0, 0, 0);
      if (key >= kvalid0) kreg[i] = *(const uint4*)(Kb + (ptrdiff_t)key * kstride + ch * 8);
    }
#pragma unroll
    for (int i = 0; i < 8; i++) {
      vreg[i] = make_uint4(0, 0, 0, 0);
      if (tid >= kvalid0) vreg[i] = *(const uint4*)(Vb + (ptrdiff_t)tid * kstride + i * 8);
    }
#pragma unroll
    for (int i = 0; i < 8; i++) {
      int idx = tid + i * 256; int key = idx >> 3, ch = idx & 7;
      *(uint4*)(sK + key * 128 + ((ch ^ ((key >> 1) & 7)) << 4)) = kreg[i];
    }
#pragma unroll
    for (int i = 0; i < 8; i++) {
      const uint4 v = vreg[i];
      u16* d = sVt + (i * 8) * 264 + tid;
      d[0 * 264] = (u16)(v.x & 0xffff); d[1 * 264] = (u16)(v.x >> 16);
      d[2 * 264] = (u16)(v.y & 0xffff); d[3 * 264] = (u16)(v.y >> 16);
      d[4 * 264] = (u16)(v.z & 0xffff); d[5 * 264] = (u16)(v.z >> 16);
      d[6 * 264] = (u16)(v.w & 0xffff); d[7 * 264] = (u16)(v.w >> 16);
    }
  }
  __syncthreads();
  const float slope = gq ? slope1 : slope0;
  const float sinkv = gq ? sink1 : sink0;
  for (int it = it0; it < it1; it++) {
    const int tq = tbase + it * 16 + r16;
    bf16x8 qf[2];
    qf[0] = qn[0]; qf[1] = qn[1];
    if (it + 1 < it1) {
      const u16* qpn = Qb + (size_t)(tq + 16) * qstride + gq * 64;
      qn[0] = *(const bf16x8*)(qpn + quad * 8);
      qn[1] = *(const bf16x8*)(qpn + 32 + quad * 8);
    }
    f32x4 s[16];
#pragma unroll
    for (int kf = 0; kf < 16; kf++) {
      s[kf] = (f32x4){0.f, 0.f, 0.f, 0.f};
      const int key = kf * 16 + r16;
      const int swz = (key >> 1) & 7;
#pragma unroll
      for (int ks = 0; ks < 2; ks++) {
        bf16x8 a = *(const bf16x8*)(sK + key * 128 + (((ks * 4 + quad) ^ swz) << 4));
        s[kf] = __builtin_amdgcn_mfma_f32_16x16x32_bf16(a, qf[ks], s[kf], 0, 0, 0);
      }
      if ((kf & 3) == 3) __builtin_amdgcn_sched_barrier(0);
    }
    float mx = -1e30f;
#pragma unroll
    for (int kf = 0; kf < 16; kf++)
#pragma unroll
      for (int j = 0; j < 4; j++) {
        float v = s[kf][j] * 0.125f;
        if (mode) {
          const int key = kf * 16 + quad * 4 + j;
          const int rel = tq + 128 - key;
          const bool ok = (rel >= 0) && (rel <= 128) && (key >= kvalid0);
          v = ok ? (v - slope * (float)rel) : -1e30f;
        }
        s[kf][j] = v;
        mx = fmaxf(mx, v);
      }
    mx = fmaxf(mx, __shfl_xor(mx, 16));
    mx = fmaxf(mx, __shfl_xor(mx, 32));
    if (mode) mx = fmaxf(mx, sinkv);
    float sum = 0.f;
#pragma unroll
    for (int kf = 0; kf < 16; kf++)
#pragma unroll
      for (int j = 0; j < 4; j++) {
        float e = __expf(s[kf][j] - mx);
        s[kf][j] = e;
        sum += e;
      }
    sum += __shfl_xor(sum, 16);
    sum += __shfl_xor(sum, 32);
    if (mode) sum += __expf(sinkv - mx);
    const float inv = 1.f / sum;
    f32x4 o[4];
#pragma unroll
    for (int df = 0; df < 4; df++) o[df] = (f32x4){0.f, 0.f, 0.f, 0.f};
#pragma unroll
    for (int st = 0; st < 8; st++) {
      u32x4 pbu;
      pbu[0] = pack2(s[2 * st][0], s[2 * st][1]);
      pbu[1] = pack2(s[2 * st][2], s[2 * st][3]);
      pbu[2] = pack2(s[2 * st + 1][0], s[2 * st + 1][1]);
      pbu[3] = pack2(s[2 * st + 1][2], s[2 * st + 1][3]);
      const bf16x8 pbv = __builtin_bit_cast(bf16x8, pbu);
#pragma unroll
      for (int df = 0; df < 4; df++) {
        const u16* vp = sVt + (df * 16 + r16) * 264 + st * 32 + quad * 4;
        const u32x2 v0 = *(const u32x2*)vp;
        const u32x2 v1 = *(const u32x2*)(vp + 16);
        u32x4 vau; vau[0] = v0[0]; vau[1] = v0[1]; vau[2] = v1[0]; vau[3] = v1[1];
        o[df] = __builtin_amdgcn_mfma_f32_16x16x32_bf16(__builtin_bit_cast(bf16x8, vau), pbv, o[df], 0, 0, 0);
      }
      if (st & 1) __builtin_amdgcn_sched_barrier(0);
    }
    u16* op = Ob + (size_t)tq * ostride + gq * 64;
#pragma unroll
    for (int df = 0; df < 4; df++) {
      uint2 pk;
      pk.x = pack2(o[df][0] * inv, o[df][1] * inv);
      pk.y = pack2(o[df][2] * inv, o[df][3] * inv);
      *(uint2*)(op + df * 16 + quad * 4) = pk;
    }
  }
}

template <int mode>
DEVI void attn_small_item(const Params& p, int l, int sb, int hh, char* smem) {
  float* qs = (float*)smem;
  float* sc = qs + 512;
  float* red = sc + 2048;
  float* rinv = red + 2048;
  const int tid = tidx(), lane = tid & 63, w = tid >> 6;
  constexpr int nq = mode ? 8 : 4, nkeys = mode ? 132 : 256;
  constexpr int NV = mode ? 34 : 32;
  const int rowbase = T_P + sb * 4;
  const u16* proj = (const u16*)(p.ws + WS_PROJ);
  const u16* qx = (const u16*)(p.ws + WS_QX);
  const int sub = lane >> 4, dl = lane & 15;
  float4 kvs[16];
#pragma unroll
  for (int u = 0; u < 16; u++) {
    const int key = w * 4 + u * 16 + sub;
    float4 kv = make_float4(0.f, 0.f, 0.f, 0.f);
    if (key < nkeys) {
      if (mode) {
        if (key < 128) { const f32x4 t4 = ldnt4(p.cache_swa_k + (((size_t)l * 128 + sb) * 128 + key) * 128 + hh * 64 + dl * 4); kv = make_float4(t4[0], t4[1], t4[2], t4[3]); }
        else {
          uint2 uu = *(const uint2*)(proj + (size_t)(rowbase + key - 128) * DIN + C_AK + hh * 64 + dl * 4);
          kv = make_float4(blo(uu.x), bhi(uu.x), blo(uu.y), bhi(uu.y));
        }
      } else {
        { const f32x4 t4 = ldnt4(p.cache_mem_k + (((size_t)l * 128 + sb) * 256 + key) * 256 + hh * 64 + dl * 4); kv = make_float4(t4[0], t4[1], t4[2], t4[3]); }
      }
    }
    kvs[u] = kv;
  }
  float qv[2];
#pragma unroll
  for (int i = 0; i < 2; i++) {
    const int e = tid + i * 256;
    qv[i] = 0.f;
    if (e < nq * 64) {
      const int qi = e >> 6, d = e & 63;
      if (mode) { const int t = qi >> 1, g = qi & 1; qv[i] = b2f(proj[(size_t)(rowbase + t) * DIN + C_AQ + (hh * 2 + g) * 64 + d]); }
      else qv[i] = b2f(qx[(size_t)(rowbase + qi) * 256 + hh * 64 + d]);
    }
  }
  __syncthreads();
#pragma unroll
  for (int i = 0; i < 2; i++) { const int e = tid + i * 256; if (e < nq * 64) qs[e] = qv[i] * 0.125f; }
  __syncthreads();
  {
    float4 qr[8];
#pragma unroll
    for (int qi = 0; qi < 8; qi++) qr[qi] = (qi < nq) ? *(const float4*)(qs + qi * 64 + dl * 4) : make_float4(0, 0, 0, 0);
#pragma unroll
    for (int u = 0; u < 16; u++) {
      const int key = w * 4 + u * 16 + sub;
      const float4 kv = kvs[u];
#pragma unroll
      for (int qi = 0; qi < 8; qi++) {
        if (qi < nq) {
          float d = kv.x * qr[qi].x + kv.y * qr[qi].y + kv.z * qr[qi].z + kv.w * qr[qi].w;
          d += __shfl_xor(d, 1); d += __shfl_xor(d, 2); d += __shfl_xor(d, 4); d += __shfl_xor(d, 8);
          if (mode) {
            const int t = qi >> 1, g = qi & 1;
            const int rel = t + 128 - key;
            const float slope = exp2f(-2.f * (float)(hh * 2 + g + 1));
            d = (rel >= 0 && rel <= 128) ? d - slope * (float)rel : -1e30f;
          }
          if (dl == 0 && key < nkeys) sc[key * 8 + qi] = d;
        }
      }
    }
  }
  __syncthreads();
  float o[8];
#pragma unroll
  for (int qi = 0; qi < 8; qi++) o[qi] = 0.f;
  for (int k0 = 0; k0 < nkeys; k0 += NV * 4) {
    float vvs[NV];
#pragma unroll
    for (int u = 0; u < NV; u++) {
      const int key = k0 + u * 4 + w;
      float vv = 0.f;
      if (key < nkeys) {
        if (mode) {
          if (key < 128) vv = ldnt1(p.cache_swa_v + (((size_t)l * 128 + sb) * 128 + key) * 128 + hh * 64 + lane);
          else vv = b2f(proj[(size_t)(rowbase + key - 128) * DIN + C_AV + hh * 64 + lane]);
        } else {
          vv = ldnt1(p.cache_mem_v + (((size_t)l * 128 + sb) * 256 + key) * 256 + hh * 64 + lane);
        }
      }
      vvs[u] = vv;
    }
    if (k0 == 0) {
      for (int qi = w; qi < nq; qi += 4) {
        float mx = -1e30f;
        for (int k = lane; k < nkeys; k += 64) mx = fmaxf(mx, sc[k * 8 + qi]);
        mx = wmaxf(mx);
        float sinkv = 0.f;
        if (mode) { sinkv = p.attn_sink[l * 4 + hh * 2 + (qi & 1)]; mx = fmaxf(mx, sinkv); }
        float sum = 0.f;
        for (int k = lane; k < nkeys; k += 64) { float e = __expf(sc[k * 8 + qi] - mx); sc[k * 8 + qi] = e; sum += e; }
        sum = wsum(sum);
        if (mode) sum += __expf(sinkv - mx);
        if (lane == 0) rinv[qi] = 1.f / sum;
      }
      __syncthreads();
    }
#pragma unroll
    for (int u = 0; u < NV; u++) {
      const int key = k0 + u * 4 + w;
      if (key < nkeys) {
        const float vv = vvs[u];
        const float4 p0 = *(const float4*)(sc + key * 8);
        const float4 p1 = *(const float4*)(sc + key * 8 + 4);
        o[0] += p0.x * vv; o[1] += p0.y * vv; o[2] += p0.z * vv; o[3] += p0.w * vv;
        o[4] += p1.x * vv; o[5] += p1.y * vv; o[6] += p1.z * vv; o[7] += p1.w * vv;
      }
    }
  }
#pragma unroll
  for (int qi = 0; qi < 8; qi++) red[(w * 8 + qi) * 64 + lane] = o[qi];
  __syncthreads();
  for (int e = tid; e < nq * 64; e += 256) {
    int qi = e >> 6, d = e & 63;
    float v = (red[(0 * 8 + qi) * 64 + d] + red[(1 * 8 + qi) * 64 + d] + red[(2 * 8 + qi) * 64 + d] + red[(3 * 8 + qi) * 64 + d]) * rinv[qi];
    if (mode) {
      int t = qi >> 1, g = qi & 1;
      ((u16*)(p.ws + WS_MIX))[(size_t)(rowbase + t) * 1024 + (hh * 2 + g) * 64 + d] = f2b(v);
    } else {
      ((u16*)(p.ws + WS_OX))[(size_t)(rowbase + qi) * 256 + hh * 64 + d] = f2b(v);
    }
  }
}

using f32x2 = __attribute__((ext_vector_type(2))) float;
constexpr int HSUB = 32;
template <bool WANT_O, bool WANT_D>
DEVI void hgrn_item(const Params& p, int l, int row0, int ntok, int h, const float* __restrict__ Sinit, float* __restrict__ Sout,
                    float* __restrict__ Dout, char* smem) {
  float* sk = (float*)smem;
  float* sq = sk + HSUB * 64;
  float* sv = sq + HSUB * 64;
  float* sop = sv + HSUB * 64;
  const int tid = tidx(), lane = tid & 63, kq = tid >> 6;
  const u16* proj = (const u16*)(p.ws + WS_PROJ);
  f32x2 S[8], Dacc[8];
#pragma unroll
  for (int i = 0; i < 8; i++) {
    S[i][0] = Sinit ? Sinit[(kq * 16 + 2 * i) * 64 + lane] : 0.f;
    S[i][1] = Sinit ? Sinit[(kq * 16 + 2 * i + 1) * 64 + lane] : 0.f;
    Dacc[i] = (f32x2){1.f, 1.f};
  }
  const int col = h * 64 + lane;
  float lb;
  {
    float a0 = p.hgrn_lb[col], a1 = p.hgrn_lb[256 + col], a2 = p.hgrn_lb[512 + col], a3 = p.hgrn_lb[768 + col];
    float m = fmaxf(fmaxf(a0, a1), fmaxf(a2, a3));
    float e0 = __expf(a0 - m), e1 = __expf(a1 - m), e2 = __expf(a2 - m), e3 = __expf(a3 - m);
    float z = 1.f / (e0 + e1 + e2 + e3);
    lb = (l == 0) ? 0.f : (l == 1) ? e1 * z : (l == 2) ? (e1 + e2) * z : (e1 + e2 + e3) * z;
  }
  constexpr int NST = HSUB / 4;
  u16 rq[NST], rf[NST], ri[NST];
#pragma unroll
  for (int i = 0; i < NST; i++) {
    const int tt = kq + 4 * i;
    rq[i] = 0; rf[i] = 0; ri[i] = 0;
    if (tt < ntok) {
      const u16* pr = proj + (size_t)(row0 + tt) * DIN;
      if (WANT_O) rq[i] = pr[C_BQ + col];
      rf[i] = pr[C_BF + col]; ri[i] = pr[C_BI + col];
    }
  }
  for (int t0 = 0; t0 < ntok; t0 += HSUB) {
    const int nt = min(HSUB, ntok - t0);
    __syncthreads();
#pragma unroll
    for (int i = 0; i < NST; i++) {
      const int tt = kq + 4 * i;
      if (tt < nt) {
        float fp = b2f(rf[i]);
        fp = fminf(fmaxf(fp, -30.f), 30.f);
        float e = __expf(-fp);
        float sg = __builtin_amdgcn_rcpf(1.f + e);
        float sgn = e * sg;
        sk[tt * 64 + lane] = (1.f - lb) * sgn;
        if (WANT_O) sq[tt * 64 + lane] = siluf_(b2f(rq[i]));
        sv[tt * 64 + lane] = b2f(ri[i]);
      }
    }
    if (t0 + HSUB < ntok) {
#pragma unroll
      for (int i = 0; i < NST; i++) {
        const int tt = t0 + HSUB + kq + 4 * i;
        if (tt < ntok) {
          const u16* pr = proj + (size_t)(row0 + tt) * DIN;
          if (WANT_O) rq[i] = pr[C_BQ + col];
          rf[i] = pr[C_BF + col]; ri[i] = pr[C_BI + col];
        }
      }
    }
    __syncthreads();
    const int ett = tid >> 4, ev4 = (tid & 15) * 4;
    float4 e_ng = make_float4(0, 0, 0, 0);
    uint2 e_gu[HSUB / 16];
#pragma unroll
    for (int ps = 0; ps < HSUB / 16; ps++) e_gu[ps] = make_uint2(0u, 0u);
    if (WANT_O) {
      e_ng = *(const float4*)(p.hgrn_norm_g + l * 256 + h * 64 + ev4);
#pragma unroll
      for (int ps = 0; ps < HSUB / 16; ps++)
        if (ps * 16 + ett < nt) e_gu[ps] = *(const uint2*)(proj + (size_t)(row0 + t0 + ps * 16 + ett) * DIN + C_BG + h * 64 + ev4);
    }
#pragma unroll 4
    for (int tt = 0; tt < nt; tt++) {
      const float vv = sv[tt * 64 + lane];
      const f32x2 vv2 = {vv, vv};
      f32x2 o2 = {0.f, 0.f};
#pragma unroll
      for (int i4 = 0; i4 < 4; i4++) {
        const f32x4 k4 = *(const f32x4*)(sk + tt * 64 + kq * 16 + i4 * 4);
        const f32x2 ka = {k4[0], k4[1]}, kb = {k4[2], k4[3]};
        S[i4 * 2] = S[i4 * 2] + ka * (vv2 - S[i4 * 2]);
        S[i4 * 2 + 1] = S[i4 * 2 + 1] + kb * (vv2 - S[i4 * 2 + 1]);
        if (WANT_D) { Dacc[i4 * 2] *= ((f32x2){1.f, 1.f} - ka); Dacc[i4 * 2 + 1] *= ((f32x2){1.f, 1.f} - kb); }
        if (WANT_O) {
          const f32x4 q4 = *(const f32x4*)(sq + tt * 64 + kq * 16 + i4 * 4);
          const f32x2 qa = {q4[0], q4[1]}, qb = {q4[2], q4[3]};
          o2 += qa * S[i4 * 2];
          o2 += qb * S[i4 * 2 + 1];
        }
      }
      if (WANT_O) sop[(kq * HSUB + tt) * 64 + lane] = o2[0] + o2[1];
    }
    if (WANT_O) {
      __syncthreads();
#pragma unroll
      for (int ps = 0; ps < HSUB / 16; ps++) {
        const int tt = ps * 16 + ett, v4 = ev4;
        const bool act = tt < nt;
        float4 o4 = make_float4(0, 0, 0, 0);
        if (act) {
#pragma unroll
          for (int k4 = 0; k4 < 4; k4++) {
            const float4 x = *(const float4*)(sop + (k4 * HSUB + tt) * 64 + v4);
            o4.x += x.x; o4.y += x.y; o4.z += x.z; o4.w += x.w;
          }
        }
        float ss = o4.x * o4.x + o4.y * o4.y + o4.z * o4.z + o4.w * o4.w;
        ss += __shfl_xor(ss, 1); ss += __shfl_xor(ss, 2); ss += __shfl_xor(ss, 4); ss += __shfl_xor(ss, 8);
        if (act) {
          const float rs = rsqrtf(ss * (1.f / 64.f) + 1e-6f);
          const int row = row0 + t0 + tt;
          const float4 ng = e_ng;
          const uint2 gu = e_gu[ps];
          uint2 pk;
          pk.x = pack2(o4.x * rs * ng.x * siluf_(blo(gu.x)), o4.y * rs * ng.y * siluf_(bhi(gu.x)));
          pk.y = pack2(o4.z * rs * ng.z * siluf_(blo(gu.y)), o4.w * rs * ng.w * siluf_(bhi(gu.y)));
          *(uint2*)((u16*)(p.ws + WS_MIX) + (size_t)row * 1024 + 256 + h * 64 + v4) = pk;
        }
      }
    }
  }
  if (Sout) {
#pragma unroll
    for (int i = 0; i < 8; i++) {
      Sout[(kq * 16 + 2 * i) * 64 + lane] = S[i][0];
      Sout[(kq * 16 + 2 * i + 1) * 64 + lane] = S[i][1];
    }
  }
  if (WANT_D) {
    if (Dout && lane == 0) {
#pragma unroll
      for (int i = 0; i < 8; i++) { Dout[kq * 16 + 2 * i] = Dacc[i][0]; Dout[kq * 16 + 2 * i + 1] = Dacc[i][1]; }
    }
  }
}

using bf16x4 = __attribute__((ext_vector_type(4))) short;
template <bool WANT_O>
DEVI void hgrn_mfma_item(const Params& p, int l, int row0, int h, const float* __restrict__ Sinit, float* __restrict__ Uout,
                         float* __restrict__ Dout, char* smem) {
  float* LF = (float*)smem;
  u16* KKb = (u16*)(smem + 16384);
  u16* Qb = (u16*)(smem + 24576);
  u16* VT = (u16*)(smem + 32768);
  u16* QH = (u16*)(smem + 41984);
  u16* KH = (u16*)(smem + 44288);
  u16* KTT = (u16*)(smem + 46592);
  u16* ST = (u16*)(smem + 48640);
  float* RED = (float*)(smem + 57856);
  const int tid = tidx(), lane = tid & 63, w = tid >> 6, r16 = lane & 15, quad = lane >> 4;
  const u16* proj = (const u16*)(p.ws + WS_PROJ);
  const int col = h * 64 + (tid & 63);
  float lb;
  {
    float a0 = p.hgrn_lb[col], a1 = p.hgrn_lb[256 + col], a2 = p.hgrn_lb[512 + col], a3 = p.hgrn_lb[768 + col];
    float m = fmaxf(fmaxf(a0, a1), fmaxf(a2, a3));
    float e0 = __expf(a0 - m), e1 = __expf(a1 - m), e2 = __expf(a2 - m), e3 = __expf(a3 - m);
    float z = 1.f / (e0 + e1 + e2 + e3);
    lb = (l == 0) ? 0.f : (l == 1) ? e1 * z : (l == 2) ? (e1 + e2) * z : (e1 + e2 + e3) * z;
  }
  f32x4 S[4];
#pragma unroll
  for (int nf = 0; nf < 4; nf++) {
    if (Sinit) S[nf] = *(const f32x4*)(Sinit + (size_t)(nf * 16 + r16) * 64 + 16 * w + quad * 4);
    else S[nf] = (f32x4){0.f, 0.f, 0.f, 0.f};
  }
  __syncthreads();
#pragma unroll
  for (int g4 = 0; g4 < 4; g4++) {
    u16 rq[4], rf[4], ri[4];
#pragma unroll
    for (int i = 0; i < 4; i++) {
      const int tt = w + 4 * (g4 * 4 + i);
      const u16* pr = proj + (size_t)(row0 + tt) * DIN;
      rq[i] = WANT_O ? pr[C_BQ + col] : (u16)0;
      rf[i] = pr[C_BF + col]; ri[i] = pr[C_BI + col];
    }
#pragma unroll
    for (int i = 0; i < 4; i++) {
      const int tt = w + 4 * (g4 * 4 + i);
      float fp = fminf(fmaxf(b2f(rf[i]), -30.f), 30.f);
      const float e = __expf(-fp);
      const float sg = __builtin_amdgcn_rcpf(1.f + e);
      const float kk = (1.f - lb) * e * sg;
      LF[tt * 64 + (tid & 63)] = __logf(fmaxf(1.f - kk, 1e-30f));
      KKb[tt * 64 + (tid & 63)] = f2b(kk);
      if (WANT_O) Qb[tt * 64 + (tid & 63)] = f2b(siluf_(b2f(rq[i])));
      VT[(tid & 63) * 72 + tt] = ri[i];
    }
  }
  if (WANT_O) {
#pragma unroll
    for (int nf = 0; nf < 4; nf++)
#pragma unroll
      for (int jj = 0; jj < 4; jj++) ST[(16 * w + quad * 4 + jj) * 72 + nf * 16 + r16] = f2b(S[nf][jj]);
  }
  __syncthreads();
  {
    const int k = tid & 63, i = tid >> 6;
    float run = 0.f;
#pragma unroll
    for (int tt = 0; tt < 16; tt++) { run += LF[(16 * i + tt) * 64 + k]; LF[(16 * i + tt) * 64 + k] = run; }
    __syncthreads();
    float off = 0.f;
    if (i >= 1) off += LF[15 * 64 + k];
    if (i >= 2) off += LF[31 * 64 + k];
    if (i >= 3) off += LF[47 * 64 + k];
    __syncthreads();
    if (i >= 1) {
#pragma unroll
      for (int tt = 0; tt < 16; tt++) LF[(16 * i + tt) * 64 + k] += off;
    }
    __syncthreads();
  }
  float4 ng = make_float4(0, 0, 0, 0);
  if (WANT_O) ng = *(const float4*)(p.hgrn_norm_g + l * 256 + h * 64 + 16 * w + quad * 4);
  for (int i = 0; i < 4; i++) {
    uint2 gu = make_uint2(0u, 0u);
    if (WANT_O) gu = *(const uint2*)(proj + (size_t)(row0 + 16 * i + r16) * DIN + C_BG + h * 64 + 16 * w + quad * 4);
    {
      const int t = tid >> 4, k4 = (tid & 15) * 4;
      const f32x4 ct = *(const f32x4*)(LF + (16 * i + t) * 64 + k4);
      f32x4 bi = {0.f, 0.f, 0.f, 0.f};
      if (i > 0) bi = *(const f32x4*)(LF + (16 * i - 1) * 64 + k4);
      const f32x4 bn = *(const f32x4*)(LF + (16 * i + 15) * 64 + k4);
      const u32x2 kr = *(const u32x2*)(KKb + (16 * i + t) * 64 + k4);
      const float kk0 = blo(kr[0]), kk1 = bhi(kr[0]), kk2 = blo(kr[1]), kk3 = bhi(kr[1]);
      KTT[(k4 + 0) * 16 + t] = f2b(kk0 * __expf(bn[0] - ct[0]));
      KTT[(k4 + 1) * 16 + t] = f2b(kk1 * __expf(bn[1] - ct[1]));
      KTT[(k4 + 2) * 16 + t] = f2b(kk2 * __expf(bn[2] - ct[2]));
      KTT[(k4 + 3) * 16 + t] = f2b(kk3 * __expf(bn[3] - ct[3]));
      if (WANT_O) {
        const u32x2 qr = *(const u32x2*)(Qb + (16 * i + t) * 64 + k4);
        u32x2 qo, ko;
        qo[0] = pack2(blo(qr[0]) * __expf(ct[0] - bi[0]), bhi(qr[0]) * __expf(ct[1] - bi[1]));
        qo[1] = pack2(blo(qr[1]) * __expf(ct[2] - bi[2]), bhi(qr[1]) * __expf(ct[3] - bi[3]));
        ko[0] = pack2(kk0 * __expf(fminf(bi[0] - ct[0], 60.f)), kk1 * __expf(fminf(bi[1] - ct[1], 60.f)));
        ko[1] = pack2(kk2 * __expf(fminf(bi[2] - ct[2], 60.f)), kk3 * __expf(fminf(bi[3] - ct[3], 60.f)));
        *(u32x2*)(QH + t * 72 + k4) = qo;
        *(u32x2*)(KH + t * 72 + k4) = ko;
      }
    }
    __syncthreads();
    const bf16x4 vf = *(const bf16x4*)(VT + (16 * w + r16) * 72 + 16 * i + quad * 4);
    f32x4 oacc = {0.f, 0.f, 0.f, 0.f};
    if (WANT_O) {
      bf16x8 qf[2], kf[2], sf[2];
#pragma unroll
      for (int ks = 0; ks < 2; ks++) {
        qf[ks] = *(const bf16x8*)(QH + r16 * 72 + ks * 32 + quad * 8);
        kf[ks] = *(const bf16x8*)(KH + r16 * 72 + ks * 32 + quad * 8);
        sf[ks] = *(const bf16x8*)(ST + (16 * w + r16) * 72 + ks * 32 + quad * 8);
      }
      f32x4 at = {0.f, 0.f, 0.f, 0.f};
      at = __builtin_amdgcn_mfma_f32_16x16x32_bf16(kf[0], qf[0], at, 0, 0, 0);
      at = __builtin_amdgcn_mfma_f32_16x16x32_bf16(kf[1], qf[1], at, 0, 0, 0);
      oacc = __builtin_amdgcn_mfma_f32_16x16x32_bf16(sf[0], qf[0], oacc, 0, 0, 0);
      oacc = __builtin_amdgcn_mfma_f32_16x16x32_bf16(sf[1], qf[1], oacc, 0, 0, 0);
      u32x2 pau;
      pau[0] = pack2((quad * 4 + 0 <= r16) ? at[0] : 0.f, (quad * 4 + 1 <= r16) ? at[1] : 0.f);
      pau[1] = pack2((quad * 4 + 2 <= r16) ? at[2] : 0.f, (quad * 4 + 3 <= r16) ? at[3] : 0.f);
      oacc = __builtin_amdgcn_mfma_f32_16x16x16bf16_1k(vf, __builtin_bit_cast(bf16x4, pau), oacc, 0, 0, 0);
    }
#pragma unroll
    for (int nf = 0; nf < 4; nf++) {
      const int k = nf * 16 + r16;
      const float bnk = LF[(16 * i + 15) * 64 + k];
      const float bik = (i > 0) ? LF[(16 * i - 1) * 64 + k] : 0.f;
      const float d = __expf(bnk - bik);
      const bf16x4 kt = *(const bf16x4*)(KTT + k * 16 + quad * 4);
      f32x4 sc = S[nf];
      sc[0] *= d; sc[1] *= d; sc[2] *= d; sc[3] *= d;
      S[nf] = __builtin_amdgcn_mfma_f32_16x16x16bf16_1k(vf, kt, sc, 0, 0, 0);
    }
    if (WANT_O) {
      if (i < 3) {
#pragma unroll
        for (int nf = 0; nf < 4; nf++)
#pragma unroll
          for (int jj = 0; jj < 4; jj++) ST[(16 * w + quad * 4 + jj) * 72 + nf * 16 + r16] = f2b(S[nf][jj]);
      }
      float ss = oacc[0] * oacc[0] + oacc[1] * oacc[1] + oacc[2] * oacc[2] + oacc[3] * oacc[3];
      ss += __shfl_xor(ss, 16); ss += __shfl_xor(ss, 32);
      if (quad == 0) RED[w * 16 + r16] = ss;
      __syncthreads();
      const float tot = RED[r16] + RED[16 + r16] + RED[32 + r16] + RED[48 + r16];
      const float rs = rsqrtf(tot * (1.f / 64.f) + 1e-6f);
      uint2 pk;
      pk.x = pack2(oacc[0] * rs * ng.x * siluf_(blo(gu.x)), oacc[1] * rs * ng.y * siluf_(bhi(gu.x)));
      pk.y = pack2(oacc[2] * rs * ng.z * siluf_(blo(gu.y)), oacc[3] * rs * ng.w * siluf_(bhi(gu.y)));
      *(uint2*)((u16*)(p.ws + WS_MIX) + (size_t)(row0 + 16 * i + r16) * 1024 + 256 + h * 64 + 16 * w + quad * 4) = pk;
    }
    __syncthreads();
  }
  if (Uout) {
#pragma unroll
    for (int nf = 0; nf < 4; nf++) *(f32x4*)(Uout + (size_t)(nf * 16 + r16) * 64 + 16 * w + quad * 4) = S[nf];
  }
  if (Dout && tid < 64) Dout[tid] = __expf(LF[63 * 64 + tid]);
}

DEVI void convpool_item(const Params& p, int l, int r0) {
  const int tid = tidx();
  const int cj = tid & 63;
  const u16* proj = (const u16*)(p.ws + WS_PROJ);
  for (int rr = tid >> 6; rr < 16; rr += 4) {
    const int r = r0 + rr;
    const bool isS = r >= T_P;
    const int seq = isS ? (r - T_P) >> 2 : r >> 11;
    const int t = isS ? (r - T_P) & 3 : r & 2047;
    const int Tn = isS ? 4 : 2048;
    const u16* pr = proj + (size_t)r * DIN;
    if (cj < 32) {
      const int j0 = cj * 8;
      float cb[8], u0[8], u1[8], u2[8], a[8], b[8];
      unpack8(*(const uint4*)(pr + C_CB + j0), cb);
      unpack8(*(const uint4*)(pr + C_CC + j0), a);
      unpack8(*(const uint4*)(pr + C_CH + j0), b);
#pragma unroll
      for (int i = 0; i < 8; i++) u0[i] = a[i] * b[i];
      if (t >= 1) {
        unpack8(*(const uint4*)(pr - DIN + C_CC + j0), a);
        unpack8(*(const uint4*)(pr - DIN + C_CH + j0), b);
#pragma unroll
        for (int i = 0; i < 8; i++) u1[i] = a[i] * b[i];
      } else if (isS) {
        const float* sp = p.state_conv + (((size_t)l * 128 + seq) * 2 + 1) * 256 + j0;
#pragma unroll
        for (int i = 0; i < 8; i++) u1[i] = sp[i];
      } else {
#pragma unroll
        for (int i = 0; i < 8; i++) u1[i] = 0.f;
      }
      if (t >= 2) {
        unpack8(*(const uint4*)(pr - 2 * DIN + C_CC + j0), a);
        unpack8(*(const uint4*)(pr - 2 * DIN + C_CH + j0), b);
#pragma unroll
        for (int i = 0; i < 8; i++) u2[i] = a[i] * b[i];
      } else if (isS) {
        const float* sp = p.state_conv + (((size_t)l * 128 + seq) * 2 + t) * 256 + j0;
#pragma unroll
        for (int i = 0; i < 8; i++) u2[i] = sp[i];
      } else {
#pragma unroll
        for (int i = 0; i < 8; i++) u2[i] = 0.f;
      }
      const float* cw = p.conv_w + (size_t)l * 3 * 256 + j0;
      float y[8];
#pragma unroll
      for (int i = 0; i < 8; i++) y[i] = cb[i] * (cw[i] * u2[i] + cw[256 + i] * u1[i] + cw[512 + i] * u0[i]);
      uint4 o;
      o.x = pack2(y[0], y[1]); o.y = pack2(y[2], y[3]); o.z = pack2(y[4], y[5]); o.w = pack2(y[6], y[7]);
      *(uint4*)((u16*)(p.ws + WS_MIX) + (size_t)r * 1024 + 512 + j0) = o;
      if (isS && t == Tn - 1) {
        float* dst = isS ? p.out + O_CONV_S + (((size_t)l * 128 + seq) * 2) * 256 + j0
                         : p.out + O_CONV_P + (((size_t)l * 8 + seq) * 2) * 256 + j0;
#pragma unroll
        for (int i = 0; i < 8; i++) { dst[i] = u1[i]; dst[256 + i] = u0[i]; }
      }
    } else {
      const int c0 = (cj - 32) * 8;
      const int g = (cj - 32) >> 3;
      const int wdw = 2 << g;
      float sum[8], v0[8], tmp[8];
      unpack8(*(const uint4*)(pr + C_DV + c0), v0);
#pragma unroll
      for (int i = 0; i < 8; i++) sum[i] = v0[i];
      if (!isS) {
        uint4 raw[15];
#pragma unroll
        for (int jj = 1; jj < 16; jj++)
          raw[jj - 1] = (jj < wdw && t - jj >= 0) ? *(const uint4*)(pr - (ptrdiff_t)jj * DIN + C_DV + c0) : make_uint4(0u, 0u, 0u, 0u);
#pragma unroll
        for (int jj = 1; jj < 16; jj++) {
          unpack8(raw[jj - 1], tmp);
#pragma unroll
          for (int i = 0; i < 8; i++) sum[i] += tmp[i];
        }
      } else {
        for (int jj = 1; jj < wdw; jj++) {
          const int tp = t - jj;
          if (tp >= 0) {
            unpack8(*(const uint4*)(pr - (size_t)jj * DIN + C_DV + c0), tmp);
#pragma unroll
            for (int i = 0; i < 8; i++) sum[i] += tmp[i];
          } else {
            const float* sp = p.state_pool + (((size_t)l * 128 + seq) * 15 + 15 + tp) * 256 + c0;
#pragma unroll
            for (int i = 0; i < 8; i++) sum[i] += sp[i];
          }
        }
      }
      const float cnt = isS ? (float)wdw : (float)min(t + 1, wdw);
      const float ic = 1.f / cnt;
      float y[8];
#pragma unroll
      for (int i = 0; i < 8; i++) y[i] = sum[i] * ic - v0[i];
      uint4 o;
      o.x = pack2(y[0], y[1]); o.y = pack2(y[2], y[3]); o.z = pack2(y[4], y[5]); o.w = pack2(y[6], y[7]);
      *(uint4*)((u16*)(p.ws + WS_POOLED) + (size_t)r * 256 + c0) = o;
      if (isS && t == Tn - 1) {
        for (int i15 = 0; i15 < 15; i15++) {
          float val[8];
          if (!isS) {
            unpack8(*(const uint4*)(pr - (size_t)(14 - i15) * DIN + C_DV + c0), val);
          } else {
            const int tp = i15 - 11;
            if (tp < 0) {
              const float* sp = p.state_pool + (((size_t)l * 128 + seq) * 15 + 4 + i15) * 256 + c0;
#pragma unroll
              for (int i = 0; i < 8; i++) val[i] = sp[i];
            } else {
              unpack8(*(const uint4*)(pr - (size_t)(3 - tp) * DIN + C_DV + c0), val);
            }
          }
          float* dst = isS ? p.out + O_POOL_S + (((size_t)l * 128 + seq) * 15 + i15) * 256 + c0
                           : p.out + O_POOL_P + (((size_t)l * 8 + seq) * 15 + i15) * 256 + c0;
#pragma unroll
          for (int i = 0; i < 8; i++) dst[i] = val[i];
        }
      }
    }
  }
}

DEVI void convpool_fast(const Params& p, int l, int r0) {
  const int tid = tidx();
  const int h2 = tid >> 7, cc = tid & 127;
  const u16* proj = (const u16*)(p.ws + WS_PROJ);
  const int rs = r0 + h2 * 8;
  const int ts = rs & 2047;
  if (cc < 64) {
    const int j0 = cc * 4;
    u32x2 rc[10], rh[10], rb[8];
#pragma unroll
    for (int i = 0; i < 10; i++) {
      const bool ok = (ts + i - 2) >= 0;
      const u16* pr = proj + (ptrdiff_t)(rs + i - 2) * DIN;
      rc[i] = ok ? *(const u32x2*)(pr + C_CC + j0) : (u32x2){0u, 0u};
      rh[i] = ok ? *(const u32x2*)(pr + C_CH + j0) : (u32x2){0u, 0u};
    }
#pragma unroll
    for (int i = 0; i < 8; i++) rb[i] = *(const u32x2*)(proj + (size_t)(rs + i) * DIN + C_CB + j0);
    const float4 w0 = *(const float4*)(p.conv_w + (size_t)l * 768 + j0);
    const float4 w1 = *(const float4*)(p.conv_w + (size_t)l * 768 + 256 + j0);
    const float4 w2 = *(const float4*)(p.conv_w + (size_t)l * 768 + 512 + j0);
    float u[10][4];
#pragma unroll
    for (int i = 0; i < 10; i++) {
      u[i][0] = blo(rc[i][0]) * blo(rh[i][0]); u[i][1] = bhi(rc[i][0]) * bhi(rh[i][0]);
      u[i][2] = blo(rc[i][1]) * blo(rh[i][1]); u[i][3] = bhi(rc[i][1]) * bhi(rh[i][1]);
    }
#pragma unroll
    for (int i = 0; i < 8; i++) {
      const float y0 = blo(rb[i][0]) * (w0.x * u[i][0] + w1.x * u[i + 1][0] + w2.x * u[i + 2][0]);
      const float y1 = bhi(rb[i][0]) * (w0.y * u[i][1] + w1.y * u[i + 1][1] + w2.y * u[i + 2][1]);
      const float y2 = blo(rb[i][1]) * (w0.z * u[i][2] + w1.z * u[i + 1][2] + w2.z * u[i + 2][2]);
      const float y3 = bhi(rb[i][1]) * (w0.w * u[i][3] + w1.w * u[i + 1][3] + w2.w * u[i + 2][3]);
      u32x2 o; o[0] = pack2(y0, y1); o[1] = pack2(y2, y3);
      *(u32x2*)((u16*)(p.ws + WS_MIX) + (size_t)(rs + i) * 1024 + 512 + j0) = o;
    }
  } else {
    const int c0 = (cc - 64) * 4;
    const int g = c0 >> 6;
    const int wdw = 2 << g;
    u32x2 rv[23];
#pragma unroll
    for (int i = 0; i < 23; i++) {
      const bool ok = (i >= 16 - wdw) && (ts + i - 15) >= 0;
      rv[i] = ok ? *(const u32x2*)(proj + (ptrdiff_t)(rs + i - 15) * DIN + C_DV + c0) : (u32x2){0u, 0u};
    }
    float v[23][4];
#pragma unroll
    for (int i = 0; i < 23; i++) { v[i][0] = blo(rv[i][0]); v[i][1] = bhi(rv[i][0]); v[i][2] = blo(rv[i][1]); v[i][3] = bhi(rv[i][1]); }
#pragma unroll
    for (int i = 0; i < 8; i++) {
      float s0 = 0.f, s1 = 0.f, s2 = 0.f, s3 = 0.f;
#pragma unroll
      for (int jj = 0; jj < 16; jj++) {
        if (jj < wdw) { s0 += v[15 + i - jj][0]; s1 += v[15 + i - jj][1]; s2 += v[15 + i - jj][2]; s3 += v[15 + i - jj][3]; }
      }
      const float ic = 1.f / (float)min(ts + i + 1, wdw);
      u32x2 o;
      o[0] = pack2(s0 * ic - v[15 + i][0], s1 * ic - v[15 + i][1]);
      o[1] = pack2(s2 * ic - v[15 + i][2], s3 * ic - v[15 + i][3]);
      *(u32x2*)((u16*)(p.ws + WS_POOLED) + (size_t)(rs + i) * 256 + c0) = o;
    }
  }
}

DEVI void convpool_sample(const Params& p, int l, int sb) {
  const int tid = tidx();
  const int t = tid >> 6, cj = tid & 63;
  const u16* proj = (const u16*)(p.ws + WS_PROJ);
  const int r = T_P + sb * 4 + t;
  const u16* pr = proj + (size_t)r * DIN;
  if (cj < 32) {
    const int j0 = cj * 8;
    float cb[8], u0[8], u1[8], u2[8], a[8], b[8];
    unpack8(*(const uint4*)(pr + C_CB + j0), cb);
    unpack8(*(const uint4*)(pr + C_CC + j0), a);
    unpack8(*(const uint4*)(pr + C_CH + j0), b);
#pragma unroll
    for (int i = 0; i < 8; i++) u0[i] = a[i] * b[i];
    if (t >= 1) {
      unpack8(*(const uint4*)(pr - DIN + C_CC + j0), a);
      unpack8(*(const uint4*)(pr - DIN + C_CH + j0), b);
#pragma unroll
      for (int i = 0; i < 8; i++) u1[i] = a[i] * b[i];
    } else {
      const float* sp = p.state_conv + (((size_t)l * 128 + sb) * 2 + 1) * 256 + j0;
      const float4 s0 = *(const float4*)sp, s1 = *(const float4*)(sp + 4);
      u1[0] = s0.x; u1[1] = s0.y; u1[2] = s0.z; u1[3] = s0.w; u1[4] = s1.x; u1[5] = s1.y; u1[6] = s1.z; u1[7] = s1.w;
    }
    if (t >= 2) {
      unpack8(*(const uint4*)(pr - 2 * DIN + C_CC + j0), a);
      unpack8(*(const uint4*)(pr - 2 * DIN + C_CH + j0), b);
#pragma unroll
      for (int i = 0; i < 8; i++) u2[i] = a[i] * b[i];
    } else {
      const float* sp = p.state_conv + (((size_t)l * 128 + sb) * 2 + t) * 256 + j0;
      const float4 s0 = *(const float4*)sp, s1 = *(const float4*)(sp + 4);
      u2[0] = s0.x; u2[1] = s0.y; u2[2] = s0.z; u2[3] = s0.w; u2[4] = s1.x; u2[5] = s1.y; u2[6] = s1.z; u2[7] = s1.w;
    }
    const float* cw = p.conv_w + (size_t)l * 768 + j0;
    float y[8];
#pragma unroll
    for (int i = 0; i < 8; i++) y[i] = cb[i] * (cw[i] * u2[i] + cw[256 + i] * u1[i] + cw[512 + i] * u0[i]);
    uint4 o;
    o.x = pack2(y[0], y[1]); o.y = pack2(y[2], y[3]); o.z = pack2(y[4], y[5]); o.w = pack2(y[6], y[7]);
    *(uint4*)((u16*)(p.ws + WS_MIX) + (size_t)r * 1024 + 512 + j0) = o;
    if (t == 3) {
      float* dst = p.out + O_CONV_S + (((size_t)l * 128 + sb) * 2) * 256 + j0;
#pragma unroll
      for (int i = 0; i < 8; i++) { dst[i] = u1[i]; dst[256 + i] = u0[i]; }
    }
  } else {
    const int c0 = (cj - 32) * 8;
    const int g = (cj - 32) >> 3;
    const int wdw = 2 << g;
    const float* spool = p.state_pool + ((size_t)l * 128 + sb) * 15 * 256 + c0;
    float sum[8], v0[8];
    unpack8(*(const uint4*)(pr + C_DV + c0), v0);
#pragma unroll
    for (int i = 0; i < 8; i++) sum[i] = v0[i];
#pragma unroll
    for (int jj = 1; jj < 16; jj++) {
      if (jj < wdw) {
        const int tp = t - jj;
        if (tp >= 0) {
          float tmp[8];
          unpack8(*(const uint4*)(pr - (ptrdiff_t)jj * DIN + C_DV + c0), tmp);
#pragma unroll
          for (int i = 0; i < 8; i++) sum[i] += tmp[i];
        } else {
          const float4 s0 = *(const float4*)(spool + (size_t)(15 + tp) * 256), s1 = *(const float4*)(spool + (size_t)(15 + tp) * 256 + 4);
          sum[0] += s0.x; sum[1] += s0.y; sum[2] += s0.z; sum[3] += s0.w; sum[4] += s1.x; sum[5] += s1.y; sum[6] += s1.z; sum[7] += s1.w;
        }
      }
    }
    const float ic = 1.f / (float)wdw;
    float y[8];
#pragma unroll
    for (int i = 0; i < 8; i++) y[i] = sum[i] * ic - v0[i];
    uint4 o;
    o.x = pack2(y[0], y[1]); o.y = pack2(y[2], y[3]); o.z = pack2(y[4], y[5]); o.w = pack2(y[6], y[7]);
    *(uint4*)((u16*)(p.ws + WS_POOLED) + (size_t)r * 256 + c0) = o;
    if (t == 3) {
      float* dstb = p.out + O_POOL_S + ((size_t)l * 128 + sb) * 15 * 256 + c0;
#pragma unroll
      for (int i15 = 0; i15 < 15; i15++) {
        float val[8];
        if (i15 < 11) {
          const float4 s0 = *(const float4*)(spool + (size_t)(4 + i15) * 256), s1 = *(const float4*)(spool + (size_t)(4 + i15) * 256 + 4);
          val[0] = s0.x; val[1] = s0.y; val[2] = s0.z; val[3] = s0.w; val[4] = s1.x; val[5] = s1.y; val[6] = s1.z; val[7] = s1.w;
        } else {
          unpack8(*(const uint4*)(pr - (ptrdiff_t)(14 - i15) * DIN + C_DV + c0), val);
        }
        float* dst = dstb + (size_t)i15 * 256;
        *(float4*)dst = make_float4(val[0], val[1], val[2], val[3]);
        *(float4*)(dst + 4) = make_float4(val[4], val[5], val[6], val[7]);
      }
    }
  }
}

DEVI void prompt_state_item(const Params& p, int l, int item) {
  const u16* proj = (const u16*)(p.ws + WS_PROJ);
  const int e = item * 256 + tidx();
  if (e >= 8 * 17 * 32) return;
  const int c8 = e & 31, rr = (e >> 5) % 17, b = (e >> 5) / 17;
  const int j0 = c8 * 8;
  if (rr < 2) {
    const u16* pr = proj + (size_t)(b * 2048 + 2046 + rr) * DIN;
    float a[8], c[8];
    unpack8(*(const uint4*)(pr + C_CC + j0), a);
    unpack8(*(const uint4*)(pr + C_CH + j0), c);
    float* dst = p.out + O_CONV_P + (((size_t)l * 8 + b) * 2 + rr) * 256 + j0;
#pragma unroll
    for (int i = 0; i < 8; i++) dst[i] = a[i] * c[i];
  } else {
    const int i15 = rr - 2;
    float v[8];
    unpack8(*(const uint4*)(proj + (size_t)(b * 2048 + 2033 + i15) * DIN + C_DV + j0), v);
    float* dst = p.out + O_POOL_P + (((size_t)l * 8 + b) * 15 + i15) * 256 + j0;
#pragma unroll
    for (int i = 0; i < 8; i++) dst[i] = v[i];
  }
}

DEVI void kvstate_item(const Params& p, int l, int item) {
  const u16* proj = (const u16*)(p.ws + WS_PROJ);
  const int e = item * 256 + tidx();
  if (e < 65536) {
    const int c4 = e & 31, i = (e >> 5) & 127, b = (e >> 12) & 7, which = e >> 15;
    const uint2 u = *(const uint2*)(proj + (size_t)(b * 2048 + 1920 + i) * DIN + C_AK + which * 128 + c4 * 4);
    float* dst = p.out + (which ? O_SWAV_P : O_SWAK_P) + (((size_t)l * 8 + b) * 128 + i) * 128 + c4 * 4;
    *(float4*)dst = make_float4(blo(u.x), bhi(u.x), blo(u.y), bhi(u.y));
  } else {
    const int e2 = e - 65536;
    const int c4 = e2 & 31, t = (e2 >> 5) & 3, sb = (e2 >> 7) & 127, which = e2 >> 14;
    const uint2 u = *(const uint2*)(proj + (size_t)(T_P + sb * 4 + t) * DIN + C_AK + which * 128 + c4 * 4);
    float* dst = p.out + (which ? O_SWAV_S : O_SWAK_S) + (((size_t)l * 128 + sb) * 128 + 124 + t) * 128 + c4 * 4;
    *(float4*)dst = make_float4(blo(u.x), bhi(u.x), blo(u.y), bhi(u.y));
  }
}


#define XB_TMO      128
#define XB_XCNT(j)  (256  + 64 * (j))
#define XB_XSUB(j)  (1280 + 64 * (j))
#define XB_XGEN(j)  (2304 + 64 * (j))
#define XB_TOP      3328
#define XB_TOPGEN   3392
#define XCD_BAR_WORDS 3456
#define XB_SPIN_CAP (1u << 22)
DEVI unsigned xb_ld(unsigned* p) { return __hip_atomic_load(p, __ATOMIC_RELAXED, __HIP_MEMORY_SCOPE_AGENT); }
DEVI unsigned xb_add(unsigned* p, unsigned v) { return __hip_atomic_fetch_add(p, v, __ATOMIC_RELAXED, __HIP_MEMORY_SCOPE_AGENT); }
DEVI unsigned xb_xcc_id() { return (unsigned)__builtin_amdgcn_s_getreg((3 << 11) | 20) & 0xFu; }
#define XB_SPIN(cond, bar) do { unsigned _sp = 0; while (cond) { __builtin_amdgcn_s_sleep(1); \
    if ((++_sp & 255u) == 0u) { if (xb_ld(&(bar)[XB_TMO])) break; if (_sp > XB_SPIN_CAP) { atomicAdd(&(bar)[XB_TMO], 1u); break; } } } } while (0)
struct XcdBarrier { unsigned* bar; unsigned x; volatile LAS unsigned* st; };
DEVI XcdBarrier xcd_barrier_post(unsigned* bar, volatile LAS unsigned* st) {
  XcdBarrier b; b.bar = bar; b.x = xb_xcc_id(); b.st = st;
  if (threadIdx.x == 0) (void)xb_add(&bar[XB_XCNT(b.x)], 1u);
  return b;
}
DEVI void xcd_barrier_complete(unsigned* bar, unsigned x, unsigned& nloc, unsigned& nx) {
  const unsigned G = gridDim.x * gridDim.y * gridDim.z;
  unsigned sum, cnt, mine, sp = 0u;
  for (;;) {
    sum = 0u; cnt = 0u; mine = 0u;
#pragma unroll
    for (unsigned j = 0; j < 16; ++j) { const unsigned c = xb_ld(&bar[XB_XCNT(j)]); sum += c; cnt += (c > 0u) ? 1u : 0u; mine = (j == x) ? c : mine; }
    if (sum == G) break;
    __builtin_amdgcn_s_sleep(1);
    if ((++sp & 255u) == 0u) { if (xb_ld(&bar[XB_TMO])) break; if (sp > XB_SPIN_CAP) { atomicAdd(&bar[XB_TMO], 1u); break; } }
  }
  nloc = mine > 0u ? mine : 1u; nx = cnt > 0u ? cnt : 1u;
}
DEVI void xcd_barrier(const XcdBarrier& b) {
  asm volatile("s_waitcnt vmcnt(0)" ::: "memory");
  __syncthreads();
  if (threadIdx.x == 0) {
    unsigned* bar = b.bar;
    __builtin_amdgcn_s_waitcnt(0);
    unsigned nloc = b.st[0], nx = b.st[1];
    if (nloc == 0u) { xcd_barrier_complete(bar, b.x, nloc, nx); b.st[0] = nloc; b.st[1] = nx; }
    const unsigned old = xb_add(&bar[XB_XSUB(b.x)], 1u);
    const unsigned gen = old / nloc;
    if (old + 1u == (gen + 1u) * nloc) {
      __builtin_amdgcn_fence(__ATOMIC_RELEASE, "agent");
      asm volatile("s_waitcnt vmcnt(0)" ::: "memory");
      const unsigned og = xb_add(&bar[XB_TOP], 1u);
      const unsigned tg = og / nx;
      if (og + 1u == (tg + 1u) * nx) xb_add(&bar[XB_TOPGEN], 1u);
      else XB_SPIN(xb_ld(&bar[XB_TOPGEN]) == tg, bar);
      __builtin_amdgcn_fence(__ATOMIC_ACQUIRE, "agent");
      xb_add(&bar[XB_XGEN(b.x)], 1u);
      asm volatile("s_waitcnt vmcnt(0)" ::: "memory");
    } else {
      XB_SPIN(xb_ld(&bar[XB_XGEN(b.x)]) == gen, bar);
      __builtin_amdgcn_fence(__ATOMIC_ACQUIRE, "agent");
      asm volatile("s_waitcnt vmcnt(0)" ::: "memory");
    }
  }
  __syncthreads();
}

DEVI int xcd_first_tile() { return (blockIdx.x & 7) * (gridDim.x >> 3) + (blockIdx.x >> 3); }
DEVI int xcd_tile_step() { return gridDim.x; }
DEVI void tile_coords(int T, int MT, int NT, int& mt, int& nt) {
  const int full = MT >> 3, band = T / (8 * NT);
  if (band < full) { const int r = T - band * 8 * NT; nt = r >> 3; mt = band * 8 + (r & 7); }
  else { const int MB = MT - full * 8; const int r = T - full * 8 * NT; nt = r / MB; mt = full * 8 + r % MB; }
}

constexpr int NPHASE = 1 + 4 * 13;

DEVI void run_phase(const Params& p, int ph, char* smem) {
  if (ph == 0) { prologue_phase(p, smem); return; }
  const int l = (ph - 1) / 13, s = (ph - 1) % 13;
  u16* xb = (u16*)(p.ws + WS_XB);
  u16* proj = (u16*)(p.ws + WS_PROJ);
  u16* mix = (u16*)(p.ws + WS_MIX);
  u16* qx = (u16*)(p.ws + WS_QX);
  u16* ox = (u16*)(p.ws + WS_OX);
  u16* hb = (u16*)(p.ws + WS_H);
  const int G = gridDim.x;
  switch (s) {
    case 0: {
      const u16* Bt = (const u16*)(p.ws + WS_WIN) + (size_t)l * 2560 * 1024;
      const int n1 = 66 * 20;
      const int n2 = (l == 0) ? 16 * 16 : 0;
      for (int t = xcd_first_tile(); t < n1 + n2; t += xcd_tile_step()) {
        if (t < n1) { int mt_, nt_; tile_coords(t, 66, 20, mt_, nt_); gemm_tile256<EPI_BF16>(p, xb, 1024, Bt, 1024, mt_ * 256, nt_ * 128, proj, DIN, smem); }
        else {
          const int t2 = t - n1;
          gemm_tile<EPI_MEMKV>(p, (const u16*)(p.ws + WS_MEMP), 1024, (const u16*)(p.ws + WS_WKV), 1024, (t2 % 16) * 128, (t2 / 16) * 128, l, nullptr, 0, smem);
        }
      }
    } break;
    case 1: {
      const int N1 = 1024, N2 = 512, N3 = 256, N4 = 256, N5 = 1024 + 128, N6 = 384 + 17;
      const int tot = N1 + N2 + N3 + N4 + N5 + N6;
      for (int it = blockIdx.x; it < tot; it += G) {
        int i = it;
        if (i < N1) {
          const int b = i >> 7, c = (i >> 2) & 31, h = i & 3;
          const size_t o = ((size_t)(b * 32 + c) * 4 + h);
          hgrn_mfma_item<false>(p, l, b * 2048 + c * 64, h, nullptr, (float*)(p.ws + WS_HU) + o * 4096, (float*)(p.ws + WS_HD) + o * 64, smem);
        } else if ((i -= N1) < N2) {
          const int sb = i >> 2, h = i & 3;
          const size_t o = (((size_t)l * 128 + sb) * 4 + h) * 4096;
          hgrn_item<true, false>(p, l, T_P + sb * 4, 4, h, p.state_hgrn + o, p.out + O_HGRN_S + o, nullptr, smem);
        } else if ((i -= N2) < N3) {
          const int b = i >> 5, qb = (i >> 1) & 15, kv = i & 1;
          const int R0 = b * 2048 + qb * 128;
          const u16* Kb = proj + (ptrdiff_t)(R0 - 128) * DIN + C_AK + kv * 64;
          const u16* Vb = proj + (ptrdiff_t)(R0 - 128) * DIN + C_AV + kv * 64;
          const float s0 = exp2f(-2.f * (float)(kv * 2 + 1)), s1 = exp2f(-2.f * (float)(kv * 2 + 2));
          attn256_item(Kb, DIN, Vb, qb == 0 ? 128 : 0, proj + (size_t)R0 * DIN + kv * 128, DIN, mix + (size_t)R0 * 1024 + kv * 128, 1024, 1,
                       s0, s1, p.attn_sink[l * 4 + kv * 2], p.attn_sink[l * 4 + kv * 2 + 1], smem);
        } else if ((i -= N3) < N4) {
          attn_small_item<1>(p, l, i >> 1, i & 1, smem);
        } else if ((i -= N4) < N5) {
          if (i < 1024) convpool_fast(p, l, i * 16); else convpool_sample(p, l, i - 1024);
        } else {
          i -= N5;
          if (i < 384) kvstate_item(p, l, i); else prompt_state_item(p, l, i - 384);
        }
      }
    } break;
    case 2: {
      {
        const float* hU = (const float*)(p.ws + WS_HU);
        const float* hD = (const float*)(p.ws + WS_HD);
        float* hS = (float*)(p.ws + WS_HS);
        for (int e = blockIdx.x * 256 + tidx(); e < 8 * 4 * 4096; e += G * 256) {
          const int b = e >> 14, h = (e >> 12) & 3, kv = e & 4095, k = kv >> 6;
          float S = 0.f;
#pragma unroll
          for (int c = 0; c < 32; c++) {
            const size_t o = (size_t)(b * 32 + c) * 4 + h;
            hS[o * 4096 + kv] = S;
            S = hD[o * 64 + k] * S + hU[o * 4096 + kv];
          }
          p.out[O_HGRN_P + (((size_t)l * 8 + b) * 4 + h) * 4096 + kv] = S;
        }
      }
      const u16* Bt = (const u16*)(p.ws + WS_POOLT) + (size_t)l * 65536;
      for (int t = xcd_first_tile(); t < 132 * 2; t += xcd_tile_step()) {
        int mt_, nt_; tile_coords(t, 132, 2, mt_, nt_);
        gemm_tile<EPI_POOL>(p, (const u16*)(p.ws + WS_POOLED), 256, Bt, 256, mt_ * 128, nt_ * 128, l, nullptr, 0, smem);
      }
    } break;
    case 3: {
      for (int i = blockIdx.x; i < 1024; i += G) {
        const int b = i >> 7, c = (i >> 2) & 31, h = i & 3;
        const size_t o = ((size_t)(b * 32 + c) * 4 + h);
        hgrn_mfma_item<true>(p, l, b * 2048 + c * 64, h, (const float*)(p.ws + WS_HS) + o * 4096, nullptr, nullptr, smem);
      }
    } break;
    case 4: {
      const u16* Bt = (const u16*)(p.ws + WS_WO) + (size_t)l * 1024 * 1024;
      for (int t = xcd_first_tile(); t < 512 + 16 * 8; t += xcd_tile_step()) {
        if (t < 512) {
          int mt_, nt_; tile_coords(t, 64, 8, mt_, nt_);
          gemm_tile256<EPI_RESID>(p, mix, 1024, Bt, 1024, mt_ * 256, nt_ * 128, nullptr, 0, smem);
        } else {
          const int u_ = t - 512, tl_ = u_ / 8, q_ = u_ - tl_ * 8;
          gemm_tile256<EPI_RESID_ATOMIC>(p, mix, 1024, Bt, 1024, (64 + (tl_ & 1)) * 256, (tl_ >> 1) * 128, nullptr, 0, smem, q_ * 128, 4, q_);
        }
      }
    } break;
    case 5: ln_phase(p, 1, p.ln1_g + l * 1024, p.ln1_b + l * 1024, 8); break;
    case 6: {
      const u16* Bt = (const u16*)(p.ws + WS_WXQ) + (size_t)l * 256 * 1024;
      for (int t = xcd_first_tile(); t < 132 * 2; t += xcd_tile_step()) {
        int mt_, nt_; tile_coords(t, 132, 2, mt_, nt_);
        gemm_tile<EPI_BF16>(p, xb, 1024, Bt, 1024, mt_ * 128, nt_ * 128, l, qx, 256, smem);
      }
    } break;
    case 7: {
      const u16* mkv = (const u16*)(p.ws + WS_MEMKV);
      for (int it = blockIdx.x; it < 512 + 512; it += G) {
        if (it < 512) {
          const int hf = it & 1, i2 = it >> 1;
          const int b = i2 >> 5, h = (i2 >> 3) & 3, tb = i2 & 7;
          const u16* Kb = mkv + ((size_t)(0 * 4 + l) * 2048 + b * 256) * 256 + h * 64;
          const u16* Vb = mkv + ((size_t)(4 + l) * 2048 + b * 256) * 256 + h * 64;
          const size_t qo = (size_t)(b * 2048 + tb * 256) * 256 + h * 64;
          attn256_item(Kb, 256, Vb, 0, qx + qo, 256, ox + qo, 256, 0, 0.f, 0.f, 0.f, 0.f, smem, hf * 2, hf * 2 + 2);
        } else {
          const int i = it - 512;
          attn_small_item<0>(p, l, i >> 2, i & 3, smem);
        }
      }
    } break;
    case 8: {
      const u16* Bt = (const u16*)(p.ws + WS_WXO) + (size_t)l * 1024 * 256;
      for (int t = xcd_first_tile(); t < 512 + 16 * 2; t += xcd_tile_step()) {
        if (t < 512) {
          int mt_, nt_; tile_coords(t, 64, 8, mt_, nt_);
          gemm_tile256<EPI_RESID>(p, ox, 256, Bt, 256, mt_ * 256, nt_ * 128, nullptr, 0, smem);
        } else {
          const int u_ = t - 512, tl_ = u_ / 2, q_ = u_ - tl_ * 2;
          gemm_tile256<EPI_RESID_ATOMIC>(p, ox, 256, Bt, 256, (64 + (tl_ & 1)) * 256, (tl_ >> 1) * 128, nullptr, 0, smem, q_ * 128, 4, q_);
        }
      }
    } break;
    case 9: ln_phase(p, 1, p.ln2_g + l * 1024, p.ln2_b + l * 1024, 2); break;
    case 10: {
      const u16* Bt = (const u16*)(p.ws + WS_WGU) + (size_t)l * 5632 * 1024;
      for (int t = xcd_first_tile(); t < 66 * 44; t += xcd_tile_step()) {
        int mt_, nt_; tile_coords(t, 66, 44, mt_, nt_);
        gemm_tile256<EPI_SWIGLU>(p, xb, 1024, Bt, 1024, mt_ * 256, nt_ * 128, hb, DFF, smem);
      }
    } break;
    case 11: {
      const u16* Bt = (const u16*)(p.ws + WS_WDN) + (size_t)l * 1024 * 2816;
      for (int t = xcd_first_tile(); t < 512 + 16 * 11; t += xcd_tile_step()) {
        if (t < 512) {
          int mt_, nt_; tile_coords(t, 64, 8, mt_, nt_);
          gemm_tile256<EPI_RESID>(p, hb, DFF, Bt, DFF, mt_ * 256, nt_ * 128, nullptr, 0, smem);
        } else {
          const int u_ = t - 512, tl_ = u_ / 11, q_ = u_ - tl_ * 11;
          gemm_tile256<EPI_RESID_ATOMIC>(p, hb, DFF, Bt, DFF, (64 + (tl_ & 1)) * 256, (tl_ >> 1) * 128, nullptr, 0, smem, q_ * 256, 8, q_);
        }
      }
    } break;
    case 12: ln_phase(p, l == 3 ? 2 : 1, p.ln3_g + l * 1024, p.ln3_b + l * 1024, 11); break;
  }
}

#if MEGA
__global__ void __launch_bounds__(256, 2) mega_kernel(Params p) {
  __shared__ __attribute__((aligned(16))) char smem[SMEM_BYTES];
  __shared__ uint4 xb_words;
  cg::grid_group grid = cg::this_grid();
  if (threadIdx.x == 0) xb_words = make_uint4(0u, 0u, 0u, 0u);
  __syncthreads();
  XcdBarrier xb = xcd_barrier_post((unsigned*)(p.ws + WS_BAR), (volatile LAS unsigned*)&xb_words);
  for (int ph = 0; ph < NPHASE; ph++) {
    run_phase(p, ph, smem);
#ifdef REPEAT_MASK
    if (ph > 0 && ((REPEAT_MASK >> ((ph - 1) % 13)) & 1)) run_phase(p, ph, smem);
    if (ph == 0 && (REPEAT_MASK & 0x10000)) run_phase(p, ph, smem);
#endif
    if (p.ws == nullptr) grid.sync();
    if (ph + 1 < NPHASE) xcd_barrier(xb);
  }
}

#else
__global__ void __launch_bounds__(256, 2) phase_kernel(Params p, int ph) {
  __shared__ __attribute__((aligned(16))) char smem[SMEM_BYTES];
  run_phase(p, ph, smem);
}
#endif

extern "C" void kernel_launch(void* const* d_in, const int* in_sizes, int n_in, void* d_out, int out_size, void* d_ws, size_t ws_size,
                              hipStream_t stream) {
  if (n_in < 33 || (size_t)out_size != O_TOTAL || ws_size < WS_TOTAL) {
    fprintf(stderr, "kernel_launch: unexpected sizes n_in=%d out=%d ws=%zu need=%zu\n", n_in, out_size, ws_size, (size_t)WS_TOTAL);
    return;
  }
  Params p{};
  const float** pp = (const float**)&p;
  for (int i = 0; i < 33; i++) pp[i] = (const float*)d_in[i];
  p.out = (float*)d_out;
  p.ws = (char*)d_ws;
#if MEGA
  static int grid_blocks = 0;
  if (!grid_blocks) {
    int dev = 0, cus = 0, per_cu = 0;
    (void)hipGetDevice(&dev);
    (void)hipDeviceGetAttribute(&cus, hipDeviceAttributeMultiprocessorCount, dev);
    (void)hipOccupancyMaxActiveBlocksPerMultiprocessor(&per_cu, mega_kernel, 256, 0);
    if (per_cu > 2) per_cu = 2;
    grid_blocks = cus * per_cu;
  }
  (void)hipMemsetAsync((char*)d_ws + WS_BAR, 0, 16384, stream);
  void* args[] = {&p};
  hipError_t e = hipLaunchCooperativeKernel((void*)mega_kernel, dim3(grid_blocks), dim3(256), args, 0, stream);
  if (e != hipSuccess) fprintf(stderr, "cooperative launch failed: %s (grid %d)\n", hipGetErrorString(e), grid_blocks);
#else
  for (int ph = 0; ph < NPHASE; ph++) phase_kernel<<<512, 256, 0, stream>>>(p, ph);
#endif
}
```

```cpp
#include <hip/hip_runtime.h>
#include <hip/hip_cooperative_groups.h>
#include <cstdio>
#include <cstdint>
namespace cg = cooperative_groups;

#ifndef MEGA
#define MEGA 1
#endif

typedef unsigned short u16;
using bf16x8 = __attribute__((ext_vector_type(8))) short;
using f32x4 = __attribute__((ext_vector_type(4))) float;
using u32x4 = __attribute__((ext_vector_type(4))) unsigned;
using u32x2 = __attribute__((ext_vector_type(2))) unsigned;
#define DEVI __device__ __forceinline__
#define LAS __attribute__((address_space(3)))

constexpr int T_P = 16384, T_S = 512, T_ALL = 16896;
constexpr int DM = 1024, DIN = 2560, DFF = 2816;
constexpr float ALPHA = 1.681792830507429f;
constexpr int C_AQ = 0, C_AK = 256, C_AV = 384, C_BQ = 512, C_BF = 768, C_BI = 1024, C_BG = 1280, C_CB = 1536, C_CC = 1792, C_CH = 2048, C_DV = 2304;
constexpr size_t O_Y = 0, O_SWAK_P = 17301504, O_SWAV_P = 17825792, O_HGRN_P = 18350080, O_CONV_P = 18874368, O_POOL_P = 18890752,
                 O_MEMK_P = 19013632, O_MEMV_P = 21110784, O_SWAK_S = 23207936, O_SWAV_S = 31596544, O_HGRN_S = 39985152,
                 O_CONV_S = 48373760, O_POOL_S = 48635904, O_TOTAL = 50601984;
constexpr size_t WS_XF = 0;
constexpr size_t WS_XB = WS_XF + (size_t)T_ALL * 1024 * 4;
constexpr size_t WS_PROJ = WS_XB + (size_t)T_ALL * 1024 * 2;
constexpr size_t WS_MIX = WS_PROJ + (size_t)T_ALL * 2560 * 2;
constexpr size_t WS_POOLED = WS_MIX + (size_t)T_ALL * 1024 * 2;
constexpr size_t WS_QX = WS_POOLED + (size_t)T_ALL * 256 * 2;
constexpr size_t WS_OX = WS_QX + (size_t)T_ALL * 256 * 2;
constexpr size_t WS_H = WS_OX + (size_t)T_ALL * 256 * 2;
constexpr size_t WS_WIN = WS_H + (size_t)T_ALL * 2816 * 2;
constexpr size_t WS_WO = WS_WIN + (size_t)4 * 2560 * 1024 * 2;
constexpr size_t WS_WXQ = WS_WO + (size_t)4 * 1024 * 1024 * 2;
constexpr size_t WS_WKV = WS_WXQ + (size_t)4 * 256 * 1024 * 2;
constexpr size_t WS_WXO = WS_WKV + (size_t)2048 * 1024 * 2;
constexpr size_t WS_WGU = WS_WXO + (size_t)4 * 1024 * 256 * 2;
constexpr size_t WS_WDN = WS_WGU + (size_t)4 * 5632 * 1024 * 2;
constexpr size_t WS_POOLT = WS_WDN + (size_t)4 * 1024 * 2816 * 2;
constexpr size_t WS_MEMP = WS_POOLT + (size_t)4 * 256 * 256 * 2;
constexpr size_t WS_MEMKV = WS_MEMP + (size_t)2048 * 1024 * 2;
constexpr size_t WS_HU = WS_MEMKV + (size_t)8 * 2048 * 256 * 2;
constexpr size_t WS_HD = WS_HU + (size_t)8 * 32 * 4 * 4096 * 4;
constexpr size_t WS_HS = WS_HD + (size_t)8 * 32 * 4 * 64 * 4;
constexpr size_t WS_SLAB = WS_HS + (size_t)8 * 32 * 4 * 4096 * 4;
constexpr size_t WS_BAR = WS_SLAB + (size_t)11 * 512 * 1024 * 4;
constexpr size_t WS_TOTAL = WS_BAR + 16384;

constexpr int SMEM_BYTES = 73728;

struct Params {
  const float *x_prompt, *x_sample, *cache_swa_k, *cache_swa_v, *state_hgrn, *state_conv, *state_pool, *cache_mem_k, *cache_mem_v,
      *mem_prompt, *emb_ln_g, *emb_ln_b, *w_in, *attn_sink, *hgrn_lb, *hgrn_norm_g, *conv_w, *pool_w, *pool_scale, *w_o, *ln1_g, *ln1_b,
      *w_xq, *w_xk, *w_xv, *w_xo, *ln2_g, *ln2_b, *w_gate, *w_up, *w_down, *ln3_g, *ln3_b;
  float* out;
  char* ws;
};

DEVI int tidx() { int t = threadIdx.x; asm volatile("" : "+v"(t)); return t; }
typedef float f32x2_t __attribute__((ext_vector_type(2)));
typedef __bf16 bf16x2_t __attribute__((ext_vector_type(2)));
DEVI u16 f2b(float f) { return __builtin_bit_cast(u16, (__bf16)f); }
DEVI float b2f(u16 h) { return __uint_as_float(((unsigned)h) << 16); }
DEVI unsigned pack2(float a, float b) { return __builtin_bit_cast(unsigned, __builtin_convertvector((f32x2_t){a, b}, bf16x2_t)); }
DEVI float blo(unsigned u) { return __uint_as_float(u << 16); }
DEVI float bhi(unsigned u) { return __uint_as_float(u & 0xffff0000u); }
DEVI f32x4 ldnt4(const float* p_) { return __builtin_nontemporal_load((const f32x4*)p_); }
DEVI float ldnt1(const float* p_) { return __builtin_nontemporal_load(p_); }
DEVI void stnt4(float* p_, f32x4 v) { __builtin_nontemporal_store(v, (f32x4*)p_); }
DEVI float wsum(float v) {
#pragma unroll
  for (int o = 32; o > 0; o >>= 1) v += __shfl_xor(v, o);
  return v;
}
DEVI float wmaxf(float v) {
#pragma unroll
  for (int o = 32; o > 0; o >>= 1) v = fmaxf(v, __shfl_xor(v, o));
  return v;
}
DEVI float sigmoidf_(float x) { return __builtin_amdgcn_rcpf(1.f + __expf(-x)); }
DEVI float siluf_(float x) { return x * __builtin_amdgcn_rcpf(1.f + __expf(-x)); }
DEVI void unpack8(uint4 u, float* f) {
  f[0] = blo(u.x); f[1] = bhi(u.x); f[2] = blo(u.y); f[3] = bhi(u.y);
  f[4] = blo(u.z); f[5] = bhi(u.z); f[6] = blo(u.w); f[7] = bhi(u.w);
}

DEVI void ln_phase(const Params& p, int mode, const float* __restrict__ g, const float* __restrict__ b, int kparts = 0) {
  const int lane = tidx() & 63, w = tidx() >> 6;
  float* xf = (float*)(p.ws + WS_XF);
  u16* xb = (u16*)(p.ws + WS_XB);
  float4 gg[4], bb[4];
#pragma unroll
  for (int i = 0; i < 4; i++) { gg[i] = ((const float4*)g)[lane + 64 * i]; bb[i] = ((const float4*)b)[lane + 64 * i]; }
  const int rstep = gridDim.x * 4;
  int r = blockIdx.x * 4 + w;
  float4 v[4], vn[4];
  if (r < T_ALL) {
    const float* src = (mode == 0) ? (r < T_P ? p.x_prompt + (size_t)r * 1024 : p.x_sample + (size_t)(r - T_P) * 1024) : xf + (size_t)r * 1024;
#pragma unroll
    for (int i = 0; i < 4; i++) { if (mode == 0) { const f32x4 t4 = ldnt4(src + (size_t)(lane + 64 * i) * 4); v[i] = make_float4(t4[0], t4[1], t4[2], t4[3]); } else v[i] = ((const float4*)src)[lane + 64 * i]; }
  }
  for (; r < T_ALL; r += rstep) {
    const int rn = r + rstep;
    if (rn < T_ALL) {
      const float* srcn = (mode == 0) ? (rn < T_P ? p.x_prompt + (size_t)rn * 1024 : p.x_sample + (size_t)(rn - T_P) * 1024) : xf + (size_t)rn * 1024;
#pragma unroll
      for (int i = 0; i < 4; i++) { if (mode == 0) { const f32x4 t4 = ldnt4(srcn + (size_t)(lane + 64 * i) * 4); vn[i] = make_float4(t4[0], t4[1], t4[2], t4[3]); } else vn[i] = ((const float4*)srcn)[lane + 64 * i]; }
    }
    if (mode != 0 && r >= T_P) {
#pragma unroll
      for (int i = 0; i < 4; i++) v[i] = make_float4(0.f, 0.f, 0.f, 0.f);
      for (int qk0 = 0; qk0 < kparts; qk0 += 4) {
        float4 t4[4][4];
#pragma unroll
        for (int u = 0; u < 4; u++) {
          const float4* sl = (const float4*)((const float*)(p.ws + WS_SLAB) + ((size_t)(qk0 + u) * 512 + (r - T_P)) * 1024);
#pragma unroll
          for (int i = 0; i < 4; i++) t4[u][i] = (qk0 + u < kparts) ? sl[lane + 64 * i] : make_float4(0.f, 0.f, 0.f, 0.f);
        }
#pragma unroll
        for (int u = 0; u < 4; u++)
#pragma unroll
          for (int i = 0; i < 4; i++) { v[i].x += t4[u][i].x; v[i].y += t4[u][i].y; v[i].z += t4[u][i].z; v[i].w += t4[u][i].w; }
      }
    }
    float s = 0.f, q = 0.f;
#pragma unroll
    for (int i = 0; i < 4; i++) {
      s += v[i].x + v[i].y + v[i].z + v[i].w;
      q += v[i].x * v[i].x + v[i].y * v[i].y + v[i].z * v[i].z + v[i].w * v[i].w;
    }
#pragma unroll
    for (int o = 32; o > 0; o >>= 1) { const float s2 = __shfl_xor(s, o), q2 = __shfl_xor(q, o); s += s2; q += q2; }
    const float mu = s * (1.f / 1024.f);
    const float var = fmaxf(q * (1.f / 1024.f) - mu * mu, 0.f);
    const float rs = rsqrtf(var + 1e-5f);
#pragma unroll
    for (int i = 0; i < 4; i++) {
      float4 o;
      o.x = (v[i].x - mu) * rs * gg[i].x + bb[i].x; o.y = (v[i].y - mu) * rs * gg[i].y + bb[i].y;
      o.z = (v[i].z - mu) * rs * gg[i].z + bb[i].z; o.w = (v[i].w - mu) * rs * gg[i].w + bb[i].w;
      uint2 pk; pk.x = pack2(o.x, o.y); pk.y = pack2(o.z, o.w);
      if (mode != 2) ((uint2*)(xb + (size_t)r * 1024))[lane + 64 * i] = pk;
      if (mode == 2) stnt4(p.out + O_Y + (size_t)r * 1024 + (size_t)(lane + 64 * i) * 4, (f32x4){o.x, o.y, o.z, o.w});
    }
#pragma unroll
    for (int i = 0; i < 4; i++) v[i] = vn[i];
  }
}

DEVI void transpose_tile(const float* __restrict__ src, int N, int k0, int n0, u16* __restrict__ dst, int ldd, int mode, char* smem) {
  float* tile = (float*)smem;
  const int tid = tidx();
#pragma unroll
  for (int i = 0; i < 16; i++) {
    int idx = tid + i * 256; int kr = idx >> 6, nc = idx & 63;
    tile[kr * 65 + nc] = src[(size_t)(k0 + kr) * N + n0 + nc];
  }
  __syncthreads();
#pragma unroll
  for (int i = 0; i < 2; i++) {
    int idx = tid + i * 256; int nr = idx >> 3, kc = (idx & 7) * 8;
    int n = n0 + nr;
    int drow = (mode == 0) ? n : ((n >> 5) * 64 + (n & 31) + (mode == 2 ? 32 : 0));
    uint4 o;
    o.x = pack2(tile[(kc + 0) * 65 + nr], tile[(kc + 1) * 65 + nr]);
    o.y = pack2(tile[(kc + 2) * 65 + nr], tile[(kc + 3) * 65 + nr]);
    o.z = pack2(tile[(kc + 4) * 65 + nr], tile[(kc + 5) * 65 + nr]);
    o.w = pack2(tile[(kc + 6) * 65 + nr], tile[(kc + 7) * 65 + nr]);
    *(uint4*)(dst + (size_t)drow * ldd + k0 + kc) = o;
  }
  __syncthreads();
}

struct TJob { const float* src; u16* dst; int K, N, mode, k0, n0; };
constexpr int TR_PER_L = 3264;
DEVI TJob decode_tjob(const Params& p, int t) {
  TJob j;
  const int l = t / TR_PER_L; int tt = t % TR_PER_L;
  j.mode = 0;
  if (tt < 640) { j.src = p.w_in + (size_t)l * 1024 * 2560; j.K = 1024; j.N = 2560; j.dst = (u16*)(p.ws + WS_WIN) + (size_t)l * 2560 * 1024; }
  else if ((tt -= 640) < 256) { j.src = p.w_o + (size_t)l * 1024 * 1024; j.K = 1024; j.N = 1024; j.dst = (u16*)(p.ws + WS_WO) + (size_t)l * 1024 * 1024; }
  else if ((tt -= 256) < 64) { j.src = p.w_xq + (size_t)l * 1024 * 256; j.K = 1024; j.N = 256; j.dst = (u16*)(p.ws + WS_WXQ) + (size_t)l * 256 * 1024; }
  else if ((tt -= 64) < 64) { j.src = p.w_xk + (size_t)l * 1024 * 256; j.K = 1024; j.N = 256; j.dst = (u16*)(p.ws + WS_WKV) + (size_t)l * 256 * 1024; }
  else if ((tt -= 64) < 64) { j.src = p.w_xv + (size_t)l * 1024 * 256; j.K = 1024; j.N = 256; j.dst = (u16*)(p.ws + WS_WKV) + (size_t)(4 + l) * 256 * 1024; }
  else if ((tt -= 64) < 64) { j.src = p.w_xo + (size_t)l * 256 * 1024; j.K = 256; j.N = 1024; j.dst = (u16*)(p.ws + WS_WXO) + (size_t)l * 1024 * 256; }
  else if ((tt -= 64) < 704) { j.src = p.w_gate + (size_t)l * 1024 * 2816; j.K = 1024; j.N = 2816; j.dst = (u16*)(p.ws + WS_WGU) + (size_t)l * 5632 * 1024; j.mode = 1; }
  else if ((tt -= 704) < 704) { j.src = p.w_up + (size_t)l * 1024 * 2816; j.K = 1024; j.N = 2816; j.dst = (u16*)(p.ws + WS_WGU) + (size_t)l * 5632 * 1024; j.mode = 2; }
  else { tt -= 704; j.src = p.w_down + (size_t)l * 2816 * 1024; j.K = 2816; j.N = 1024; j.dst = (u16*)(p.ws + WS_WDN) + (size_t)l * 1024 * 2816; }
  const int nkt = j.K >> 6;
  j.k0 = (tt % nkt) * 64; j.n0 = (tt / nkt) * 64;
  return j;
}

DEVI void prologue_phase(const Params& p, char* smem) {
  ln_phase(p, 0, p.emb_ln_g, p.emb_ln_b);
  {
    const int tid = tidx();
    float* tile = (float*)smem;
    const int total = 4 * TR_PER_L;
    int t = blockIdx.x;
    float rc[16], rn[16];
    TJob jc{}, jn{};
    if (t < total) { jc = decode_tjob(p, t);
#pragma unroll
      for (int i = 0; i < 16; i++) { int idx = tid + i * 256; rc[i] = ldnt1(jc.src + (size_t)(jc.k0 + (idx >> 6)) * jc.N + jc.n0 + (idx & 63)); } }
    for (; t < total; t += gridDim.x) {
      const int tn = t + gridDim.x;
      if (tn < total) { jn = decode_tjob(p, tn);
#pragma unroll
        for (int i = 0; i < 16; i++) { int idx = tid + i * 256; rn[i] = ldnt1(jn.src + (size_t)(jn.k0 + (idx >> 6)) * jn.N + jn.n0 + (idx & 63)); } }
#pragma unroll
      for (int i = 0; i < 16; i++) { int idx = tid + i * 256; tile[(idx >> 6) * 65 + (idx & 63)] = rc[i]; }
      __syncthreads();
#pragma unroll
      for (int i = 0; i < 2; i++) {
        int idx = tid + i * 256; int nr = idx >> 3, kc = (idx & 7) * 8;
        int n = jc.n0 + nr;
        int drow = (jc.mode == 0) ? n : ((n >> 5) * 64 + (n & 31) + (jc.mode == 2 ? 32 : 0));
        uint4 o;
        o.x = pack2(tile[(kc + 0) * 65 + nr], tile[(kc + 1) * 65 + nr]);
        o.y = pack2(tile[(kc + 2) * 65 + nr], tile[(kc + 3) * 65 + nr]);
        o.z = pack2(tile[(kc + 4) * 65 + nr], tile[(kc + 5) * 65 + nr]);
        o.w = pack2(tile[(kc + 6) * 65 + nr], tile[(kc + 7) * 65 + nr]);
        *(uint4*)(jc.dst + (size_t)drow * jc.K + jc.k0 + kc) = o;
      }
      __syncthreads();
      jc = jn;
#pragma unroll
      for (int i = 0; i < 16; i++) rc[i] = rn[i];
    }
  }
  const int gtid = blockIdx.x * 256 + tidx(), gsz = gridDim.x * 256;
  {
    u16* pt = (u16*)(p.ws + WS_POOLT);
    for (int e = gtid; e < 4 * 256 * 256; e += gsz) {
      int l = e >> 16, n = (e >> 8) & 255, k = e & 255;
      int g = n >> 6, d = n & 63, g2 = k >> 6, c = k & 63;
      float v = (g == g2) ? p.pool_w[(((size_t)l * 4 + g) * 64 + c) * 64 + d] : 0.f;
      pt[e] = f2b(v);
    }
  }
  {
    u16* mp = (u16*)(p.ws + WS_MEMP);
    for (int e = gtid; e < 2048 * 1024 / 4; e += gsz) {
      float4 v = ((const float4*)p.mem_prompt)[e];
      uint2 pk; pk.x = pack2(v.x, v.y); pk.y = pack2(v.z, v.w);
      ((uint2*)mp)[e] = pk;
    }
  }
  {
    const int per = 4 * 128 * 124 * 32;
    for (int e0 = gtid; e0 < 2 * per; e0 += 4 * gsz) {
      float4 v[4];
      size_t doff[4];
      int whichv[4];
#pragma unroll
      for (int u = 0; u < 4; u++) {
        const int e = e0 + u * gsz;
        v[u] = make_float4(0, 0, 0, 0); doff[u] = 0; whichv[u] = -1;
        if (e < 2 * per) {
          int which = e / per, r = e % per;
          int c4 = r & 31; int i = (r >> 5) % 124; int ls = (r >> 5) / 124;
          const float* src = which ? p.cache_swa_v : p.cache_swa_k;
          { const f32x4 t4 = ldnt4(src + ((size_t)ls * 128 + i + 4) * 128 + c4 * 4); v[u] = make_float4(t4[0], t4[1], t4[2], t4[3]); }
          doff[u] = ((size_t)ls * 128 + i) * 128 + c4 * 4;
          whichv[u] = which;
        }
      }
#pragma unroll
      for (int u = 0; u < 4; u++)
        if (whichv[u] >= 0) stnt4(p.out + (whichv[u] ? O_SWAV_S : O_SWAK_S) + doff[u], (f32x4){v[u].x, v[u].y, v[u].z, v[u].w});
    }
  }
}

enum { EPI_BF16 = 0, EPI_RESID = 1, EPI_SWIGLU = 2, EPI_MEMKV = 3, EPI_POOL = 4, EPI_RESID_ATOMIC = 5 };

DEVI void dma16(const void* g, unsigned lds) {
  unsigned keep;
  asm volatile("s_mov_b32 %0, m0\n\ts_mov_b32 m0, %2\n\ts_nop 0\n\tglobal_load_lds_dwordx4 %1, off\n\ts_mov_b32 m0, %0"
               : "=&s"(keep) : "v"(g), "s"(lds) : "memory");
}

template <int EPI>
DEVI void gemm_tile(const Params& p, const u16* __restrict__ A, int lda, const u16* __restrict__ Bt, int K, int m0, int n0,
                          int l, u16* __restrict__ outb, int ldc, char* smem, int kbeg = 0, int nk_part = -1, bool first = true) {
  const int tid = tidx(), lane = tid & 63, wid = tid >> 6;
  const int wm = wid >> 1, wn = wid & 1, r16 = lane & 15, quad = lane >> 4;
  f32x4 acc[4][4];
#pragma unroll
  for (int i = 0; i < 4; i++)
#pragma unroll
    for (int j = 0; j < 4; j++) acc[i][j] = (f32x4){0.f, 0.f, 0.f, 0.f};
  const int nk = (nk_part < 0) ? (K >> 5) : nk_part;
  const int lrow = tid >> 2, lpc = tid & 3;
  const int lch = lpc ^ ((0x78 >> (((lrow >> 2) & 3) * 2)) & 3);
  const u16* ga = A + (size_t)(m0 + lrow) * lda + kbeg + lch * 8;
  const u16* gb = Bt + (size_t)(n0 + lrow) * K + kbeg + lch * 8;
  const size_t ga1 = (size_t)64 * lda, gb1 = (size_t)64 * K;
  const unsigned lds0 = (unsigned)(uintptr_t)(LAS char*)smem + (unsigned)__builtin_amdgcn_readfirstlane(wid) * 1024u;
#define GEMM_STAGE(kt_)                                                             \
  do {                                                                              \
    const unsigned sb_ = lds0 + (unsigned)((kt_) & 3) * 16384u;                     \
    const u16* a_ = ga + (size_t)(kt_) * 32;                                        \
    const u16* b_ = gb + (size_t)(kt_) * 32;                                        \
    dma16(a_, sb_); dma16(a_ + ga1, sb_ + 4096u);                                   \
    dma16(b_, sb_ + 8192u); dma16(b_ + gb1, sb_ + 12288u);                          \
  } while (0)
  __syncthreads();
  GEMM_STAGE(0); GEMM_STAGE(1); GEMM_STAGE(2); GEMM_STAGE(3);
  const int fsw = (0x78 >> (((r16 >> 2) & 3) * 2)) & 3;
  const int aoff = (wm * 64 + r16) * 64 + ((quad ^ fsw) << 4);
  const int boff = 8192 + (wn * 64 + r16) * 64 + ((quad ^ fsw) << 4);
  bf16x8 xa0[4], wb0[4], xa1[4], wb1[4];
#define GEMM_READ(kt_, XA, WB)                                   \
  do {                                                           \
    const char* cS_ = smem + ((kt_) & 3) * 16384;                \
    _Pragma("unroll") for (int f = 0; f < 4; f++) {              \
      XA[f] = *(const bf16x8*)(cS_ + aoff + f * 1024);           \
      WB[f] = *(const bf16x8*)(cS_ + boff + f * 1024);           \
    }                                                            \
  } while (0)
#define GEMM_MMA(XA, WB)                                                                              \
  do {                                                                                                \
    _Pragma("unroll") for (int nf = 0; nf < 4; nf++)                                                  \
      _Pragma("unroll") for (int mf = 0; mf < 4; mf++)                                                \
        acc[nf][mf] = __builtin_amdgcn_mfma_f32_16x16x32_bf16(WB[nf], XA[mf], acc[nf][mf], 0, 0, 0);  \
  } while (0)
#define GEMM_STEP(kt_, XAC, WBC, XAN, WBN)                                          \
  do {                                                                              \
    if ((kt_) + 3 < nk) asm volatile("s_waitcnt vmcnt(8)" ::: "memory");            \
    else if ((kt_) + 2 < nk) asm volatile("s_waitcnt vmcnt(4)" ::: "memory");       \
    else asm volatile("s_waitcnt vmcnt(0)" ::: "memory");                           \
    asm volatile("s_waitcnt lgkmcnt(0)" ::: "memory");                              \
    __builtin_amdgcn_s_barrier();                                                   \
    asm volatile("" ::: "memory");                                                  \
    if ((kt_) + 4 < nk) GEMM_STAGE((kt_) + 4);                                      \
    if ((kt_) + 1 < nk) GEMM_READ((kt_) + 1, XAN, WBN);                             \
    GEMM_MMA(XAC, WBC);                                                             \
  } while (0)
  asm volatile("s_waitcnt vmcnt(12)" ::: "memory");
  __builtin_amdgcn_s_barrier();
  asm volatile("" ::: "memory");
  GEMM_READ(0, xa0, wb0);
  for (int kt = 0; kt < nk; kt += 2) {
    GEMM_STEP(kt, xa0, wb0, xa1, wb1);
    GEMM_STEP(kt + 1, xa1, wb1, xa0, wb0);
  }
#undef GEMM_READ
#undef GEMM_MMA
#undef GEMM_STEP
#undef GEMM_STAGE
#pragma unroll
  for (int mf = 0; mf < 4; mf++) {
    const int row = m0 + wm * 64 + mf * 16 + r16;
    if (EPI == EPI_SWIGLU) {
#pragma unroll
      for (int nf = 0; nf < 2; nf++) {
        const int hcol = (n0 >> 1) + wn * 32 + nf * 16 + quad * 4;
        f32x4 g = acc[nf][mf], u = acc[nf + 2][mf];
        uint2 pk;
        pk.x = pack2(siluf_(g[0]) * u[0], siluf_(g[1]) * u[1]);
        pk.y = pack2(siluf_(g[2]) * u[2], siluf_(g[3]) * u[3]);
        *(uint2*)(outb + (size_t)row * DFF + hcol) = pk;
      }
    } else {
#pragma unroll
      for (int nf = 0; nf < 4; nf++) {
        const int col = n0 + wn * 64 + nf * 16 + quad * 4;
        f32x4 a = acc[nf][mf];
        if (EPI == EPI_BF16) {
          uint2 pk; pk.x = pack2(a[0], a[1]); pk.y = pack2(a[2], a[3]);
          *(uint2*)(outb + (size_t)row * ldc + col) = pk;
        } else if (EPI == EPI_RESID) {
          const u32x2 xr = *(const u32x2*)((const u16*)(p.ws + WS_XB) + (size_t)row * 1024 + col);
          f32x4 x;
          x[0] = ALPHA * blo(xr[0]) + a[0]; x[1] = ALPHA * bhi(xr[0]) + a[1]; x[2] = ALPHA * blo(xr[1]) + a[2]; x[3] = ALPHA * bhi(xr[1]) + a[3];
          *(f32x4*)((float*)(p.ws + WS_XF) + (size_t)row * 1024 + col) = x;
        } else if (EPI == EPI_RESID_ATOMIC) {
          f32x4 x = a;
          if (first) {
            const u32x2 xr = *(const u32x2*)((const u16*)(p.ws + WS_XB) + (size_t)row * 1024 + col);
            x[0] += ALPHA * blo(xr[0]); x[1] += ALPHA * bhi(xr[0]); x[2] += ALPHA * blo(xr[1]); x[3] += ALPHA * bhi(xr[1]);
          }
          *(f32x4*)((float*)(p.ws + WS_SLAB) + ((size_t)l * 512 + (row - T_P)) * 1024 + col) = x;
        } else if (EPI == EPI_MEMKV) {
          const int which = col >> 10, ll = (col >> 8) & 3, c = col & 255;
          float* dst = p.out + (which ? O_MEMV_P : O_MEMK_P) + ((size_t)ll * 2048 + row) * 256 + c;
          *(float4*)dst = make_float4(a[0], a[1], a[2], a[3]);
          uint2 pk; pk.x = pack2(a[0], a[1]); pk.y = pack2(a[2], a[3]);
          *(uint2*)((u16*)(p.ws + WS_MEMKV) + ((size_t)(which * 4 + ll) * 2048 + row) * 256 + c) = pk;
        } else if (EPI == EPI_POOL) {
          const float4 sc = *(const float4*)(p.pool_scale + l * 256 + col);
          uint2 pk; pk.x = pack2(a[0] * sc.x, a[1] * sc.y); pk.y = pack2(a[2] * sc.z, a[3] * sc.w);
          *(uint2*)((u16*)(p.ws + WS_MIX) + (size_t)row * 1024 + 768 + col) = pk;
        }
      }
    }
  }
}


template <int EPI>
DEVI void gemm_tile256(const Params& p, const u16* __restrict__ A, int lda, const u16* __restrict__ Bt, int K, int m0, int n0,
                       u16* __restrict__ outb, int ldc, char* smem, int kbeg = 0, int nk_part = -1, int kpart = 0) {
  const int tid = tidx(), lane = tid & 63, wid = tid >> 6;
  const int wm = wid >> 1, wn = wid & 1, r16 = lane & 15, quad = lane >> 4;
  f32x4 acc[4][8];
#pragma unroll
  for (int i = 0; i < 4; i++)
#pragma unroll
    for (int j = 0; j < 8; j++) acc[i][j] = (f32x4){0.f, 0.f, 0.f, 0.f};
  const int nk = (nk_part < 0) ? (K >> 5) : nk_part;
  const int lrow = tid >> 2, lpc = tid & 3;
  const int lch = lpc ^ ((0x78 >> (((lrow >> 2) & 3) * 2)) & 3);
  const u16* ga = A + (size_t)(m0 + lrow) * lda + kbeg + lch * 8;
  const u16* gb = Bt + (size_t)(n0 + lrow) * K + kbeg + lch * 8;
  const size_t ga1 = (size_t)64 * lda, gb1 = (size_t)64 * K;
  const unsigned lds0 = (unsigned)(uintptr_t)(LAS char*)smem + (unsigned)__builtin_amdgcn_readfirstlane(wid) * 1024u;
#define G2_STAGE(kt_)                                                               \
  do {                                                                              \
    const unsigned sb_ = lds0 + (unsigned)((kt_) % 3) * 24576u;                     \
    const u16* a_ = ga + (size_t)(kt_) * 32;                                        \
    const u16* b_ = gb + (size_t)(kt_) * 32;                                        \
    dma16(a_, sb_); dma16(a_ + ga1, sb_ + 4096u);                                   \
    dma16(a_ + 2 * ga1, sb_ + 8192u); dma16(a_ + 3 * ga1, sb_ + 12288u);            \
    dma16(b_, sb_ + 16384u); dma16(b_ + gb1, sb_ + 20480u);                         \
  } while (0)
  __syncthreads();
  G2_STAGE(0); G2_STAGE(1);
  const int fsw = (0x78 >> (((r16 >> 2) & 3) * 2)) & 3;
  const int aoff = (wm * 128 + r16) * 64 + ((quad ^ fsw) << 4);
  const int boff = 16384 + (wn * 64 + r16) * 64 + ((quad ^ fsw) << 4);
  for (int kt = 0; kt < nk; kt++) {
    if (kt + 1 < nk) asm volatile("s_waitcnt vmcnt(6)" ::: "memory");
    else asm volatile("s_waitcnt vmcnt(0)" ::: "memory");
    __builtin_amdgcn_s_barrier();
    asm volatile("" ::: "memory");
    if (kt + 2 < nk) G2_STAGE(kt + 2);
    const char* cS = smem + (kt % 3) * 24576;
    bf16x8 xa[8], wb[4];
#pragma unroll
    for (int f = 0; f < 8; f++) xa[f] = *(const bf16x8*)(cS + aoff + f * 1024);
#pragma unroll
    for (int f = 0; f < 4; f++) wb[f] = *(const bf16x8*)(cS + boff + f * 1024);
#pragma unroll
    for (int nf = 0; nf < 4; nf++)
#pragma unroll
      for (int mf = 0; mf < 8; mf++)
        acc[nf][mf] = __builtin_amdgcn_mfma_f32_16x16x32_bf16(wb[nf], xa[mf], acc[nf][mf], 0, 0, 0);
  }
#undef G2_STAGE
#pragma unroll
  for (int mf = 0; mf < 8; mf++) {
    const int row = m0 + wm * 128 + mf * 16 + r16;
    if (EPI == EPI_SWIGLU) {
#pragma unroll
      for (int nf = 0; nf < 2; nf++) {
        const int hcol = (n0 >> 1) + wn * 32 + nf * 16 + quad * 4;
        f32x4 g = acc[nf][mf], u = acc[nf + 2][mf];
        u32x2 pk;
        pk[0] = pack2(siluf_(g[0]) * u[0], siluf_(g[1]) * u[1]);
        pk[1] = pack2(siluf_(g[2]) * u[2], siluf_(g[3]) * u[3]);
        *(u32x2*)(outb + (size_t)row * DFF + hcol) = pk;
      }
    } else {
#pragma unroll
      for (int nf = 0; nf < 4; nf++) {
        const int col = n0 + wn * 64 + nf * 16 + quad * 4;
        f32x4 a = acc[nf][mf];
        if (EPI == EPI_RESID || EPI == EPI_RESID_ATOMIC) {
          f32x4 x = a;
          if (EPI == EPI_RESID || kpart == 0) {
            const u32x2 xr = *(const u32x2*)((const u16*)(p.ws + WS_XB) + (size_t)row * 1024 + col);
            x[0] += ALPHA * blo(xr[0]); x[1] += ALPHA * bhi(xr[0]); x[2] += ALPHA * blo(xr[1]); x[3] += ALPHA * bhi(xr[1]);
          }
          if (EPI == EPI_RESID) *(f32x4*)((float*)(p.ws + WS_XF) + (size_t)row * 1024 + col) = x;
          else *(f32x4*)((float*)(p.ws + WS_SLAB) + ((size_t)kpart * 512 + (row - T_P)) * 1024 + col) = x;
        } else {
          u32x2 pk; pk[0] = pack2(a[0], a[1]); pk[1] = pack2(a[2], a[3]);
          *(u32x2*)(outb + (size_t)row * ldc + col) = pk;
        }
      }
    }
  }
}

DEVI void attn256_item(const u16* __restrict__ Kb, int kstride, const u16* __restrict__ Vb, int kvalid0,
                             const u16* __restrict__ Qb, int qstride, u16* __restrict__ Ob, int ostride,
                             int mode, float slope0, float slope1, float sink0, float sink1, char* smem, int it0 = 0, int it1 = 4) {
  const int tid = tidx(), lane = tid & 63, w = tid >> 6, r16 = lane & 15, quad = lane >> 4;
  char* sK = smem;
  u16* sVt = (u16*)(smem + 32768);
  const int gq = mode ? (w & 1) : 0;
  const int tbase = mode ? (w >> 1) * 64 : w * 64;
  bf16x8 qn[2];
  {
    const u16* qp0 = Qb + (size_t)(tbase + it0 * 16 + r16) * qstride + gq * 64;
    qn[0] = *(const bf16x8*)(qp0 + quad * 8);
    qn[1] = *(const bf16x8*)(qp0 + 32 + quad * 8);
  }
  __syncthreads();
  {
    uint4 kreg[8], vreg[8];
#pragma unroll
    for (int i = 0; i < 8; i++) {
      int idx = tid + i * 256; int key = idx >> 3, ch = idx & 7;
      kreg[i] = make_uint4(0, 0, 0, 0);
      if (key >= kvalid0) kreg[i] = *(const uint4*)(Kb + (ptrdiff_t)key * kstride + ch * 8);
    }
#pragma unroll
    for (int i = 0; i < 8; i++) {
      vreg[i] = make_uint4(0, 0, 0, 0);
      if (tid >= kvalid0) vreg[i] = *(const uint4*)(Vb + (ptrdiff_t)tid * kstride + i * 8);
    }
#pragma unroll
    for (int i = 0; i < 8; i++) {
      int idx = tid + i * 256; int key = idx >> 3, ch = idx & 7;
      *(uint4*)(sK + key * 128 + ((ch ^ ((key >> 1) & 7)) << 4)) = kreg[i];
    }
#pragma unroll
    for (int i = 0; i < 8; i++) {
      const uint4 v = vreg[i];
      u16* d = sVt + (i * 8) * 264 + tid;
      d[0 * 264] = (u16)(v.x & 0xffff); d[1 * 264] = (u16)(v.x >> 16);
      d[2 * 264] = (u16)(v.y & 0xffff); d[3 * 264] = (u16)(v.y >> 16);
      d[4 * 264] = (u16)(v.z & 0xffff); d[5 * 264] = (u16)(v.z >> 16);
      d[6 * 264] = (u16)(v.w & 0xffff); d[7 * 264] = (u16)(v.w >> 16);
    }
  }
  __syncthreads();
  const float slope = gq ? slope1 : slope0;
  const float sinkv = gq ? sink1 : sink0;
  for (int it = it0; it < it1; it++) {
    const int tq = tbase + it * 16 + r16;
    bf16x8 qf[2];
    qf[0] = qn[0]; qf[1] = qn[1];
    if (it + 1 < it1) {
      const u16* qpn = Qb + (size_t)(tq + 16) * qstride + gq * 64;
      qn[0] = *(const bf16x8*)(qpn + quad * 8);
      qn[1] = *(const bf16x8*)(qpn + 32 + quad * 8);
    }
    f32x4 s[16];
#pragma unroll
    for (int kf = 0; kf < 16; kf++) {
      s[kf] = (f32x4){0.f, 0.f, 0.f, 0.f};
      const int key = kf * 16 + r16;
      const int swz = (key >> 1) & 7;
#pragma unroll
      for (int ks = 0; ks < 2; ks++) {
        bf16x8 a = *(const bf16x8*)(sK + key * 128 + (((ks * 4 + quad) ^ swz) << 4));
        s[kf] = __builtin_amdgcn_mfma_f32_16x16x32_bf16(a, qf[ks], s[kf], 0, 0, 0);
      }
      if ((kf & 3) == 3) __builtin_amdgcn_sched_barrier(0);
    }
    float mx = -1e30f;
#pragma unroll
    for (int kf = 0; kf < 16; kf++)
#pragma unroll
      for (int j = 0; j < 4; j++) {
        float v = s[kf][j] * 0.125f;
        if (mode) {
          const int key = kf * 16 + quad * 4 + j;
          const int rel = tq + 128 - key;
          const bool ok = (rel >= 0) && (rel <= 128) && (key >= kvalid0);
          v = ok ? (v - slope * (float)rel) : -1e30f;
        }
        s[kf][j] = v;
        mx = fmaxf(mx, v);
      }
    mx = fmaxf(mx, __shfl_xor(mx, 16));
    mx = fmaxf(mx, __shfl_xor(mx, 32));
    if (mode) mx = fmaxf(mx, sinkv);
    float sum = 0.f;
#pragma unroll
    for (int kf = 0; kf < 16; kf++)
#pragma unroll
      for (int j = 0; j < 4; j++) {
        float e = __expf(s[kf][j] - mx);
        s[kf][j] = e;
        sum += e;
      }
    sum += __shfl_xor(sum, 16);
    sum += __shfl_xor(sum, 32);
    if (mode) sum += __expf(sinkv - mx);
    const float inv = 1.f / sum;
    f32x4 o[4];
#pragma unroll
    for (int df = 0; df < 4; df++) o[df] = (f32x4){0.f, 0.f, 0.f, 0.f};
#pragma unroll
    for (int st = 0; st < 8; st++) {
      u32x4 pbu;
      pbu[0] = pack2(s[2 * st][0], s[2 * st][1]);
      pbu[1] = pack2(s[2 * st][2], s[2 * st][3]);
      pbu[2] = pack2(s[2 * st + 1][0], s[2 * st + 1][1]);
      pbu[3] = pack2(s[2 * st + 1][2], s[2 * st + 1][3]);
      const bf16x8 pbv = __builtin_bit_cast(bf16x8, pbu);
#pragma unroll
      for (int df = 0; df < 4; df++) {
        const u16* vp = sVt + (df * 16 + r16) * 264 + st * 32 + quad * 4;
        const u32x2 v0 = *(const u32x2*)vp;
        const u32x2 v1 = *(const u32x2*)(vp + 16);
        u32x4 vau; vau[0] = v0[0]; vau[1] = v0[1]; vau[2] = v1[0]; vau[3] = v1[1];
        o[df] = __builtin_amdgcn_mfma_f32_16x16x32_bf16(__builtin_bit_cast(bf16x8, vau), pbv, o[df], 0, 0, 0);
      }
      if (st & 1) __builtin_amdgcn_sched_barrier(0);
    }
    u16* op = Ob + (size_t)tq * ostride + gq * 64;
#pragma unroll
    for (int df = 0; df < 4; df++) {
      uint2 pk;
      pk.x = pack2(o[df][0] * inv, o[df][1] * inv);
      pk.y = pack2(o[df][2] * inv, o[df][3] * inv);
      *(uint2*)(op + df * 16 + quad * 4) = pk;
    }
  }
}

template <int mode>
DEVI void attn_small_item(const Params& p, int l, int sb, int hh, char* smem) {
  float* qs = (float*)smem;
  float* sc = qs + 512;
  float* red = sc + 2048;
  float* rinv = red + 2048;
  const int tid = tidx(), lane = tid & 63, w = tid >> 6;
  constexpr int nq = mode ? 8 : 4, nkeys = mode ? 132 : 256;
  constexpr int NV = mode ? 34 : 32;
  const int rowbase = T_P + sb * 4;
  const u16* proj = (const u16*)(p.ws + WS_PROJ);
  const u16* qx = (const u16*)(p.ws + WS_QX);
  const int sub = lane >> 4, dl = lane & 15;
  float4 kvs[16];
#pragma unroll
  for (int u = 0; u < 16; u++) {
    const int key = w * 4 + u * 16 + sub;
    float4 kv = make_float4(0.f, 0.f, 0.f, 0.f);
    if (key < nkeys) {
      if (mode) {
        if (key < 128) { const f32x4 t4 = ldnt4(p.cache_swa_k + (((size_t)l * 128 + sb) * 128 + key) * 128 + hh * 64 + dl * 4); kv = make_float4(t4[0], t4[1], t4[2], t4[3]); }
        else {
          uint2 uu = *(const uint2*)(proj + (size_t)(rowbase + key - 128) * DIN + C_AK + hh * 64 + dl * 4);
          kv = make_float4(blo(uu.x), bhi(uu.x), blo(uu.y), bhi(uu.y));
        }
      } else {
        { const f32x4 t4 = ldnt4(p.cache_mem_k + (((size_t)l * 128 + sb) * 256 + key) * 256 + hh * 64 + dl * 4); kv = make_float4(t4[0], t4[1], t4[2], t4[3]); }
      }
    }
    kvs[u] = kv;
  }
  float qv[2];
#pragma unroll
  for (int i = 0; i < 2; i++) {
    const int e = tid + i * 256;
    qv[i] = 0.f;
    if (e < nq * 64) {
      const int qi = e >> 6, d = e & 63;
      if (mode) { const int t = qi >> 1, g = qi & 1; qv[i] = b2f(proj[(size_t)(rowbase + t) * DIN + C_AQ + (hh * 2 + g) * 64 + d]); }
      else qv[i] = b2f(qx[(size_t)(rowbase + qi) * 256 + hh * 64 + d]);
    }
  }
  __syncthreads();
#pragma unroll
  for (int i = 0; i < 2; i++) { const int e = tid + i * 256; if (e < nq * 64) qs[e] = qv[i] * 0.125f; }
  __syncthreads();
  {
    float4 qr[8];
#pragma unroll
    for (int qi = 0; qi < 8; qi++) qr[qi] = (qi < nq) ? *(const float4*)(qs + qi * 64 + dl * 4) : make_float4(0, 0, 0, 0);
#pragma unroll
    for (int u = 0; u < 16; u++) {
      const int key = w * 4 + u * 16 + sub;
      const float4 kv = kvs[u];
#pragma unroll
      for (int qi = 0; qi < 8; qi++) {
        if (qi < nq) {
          float d = kv.x * qr[qi].x + kv.y * qr[qi].y + kv.z * qr[qi].z + kv.w * qr[qi].w;
          d += __shfl_xor(d, 1); d += __shfl_xor(d, 2); d += __shfl_xor(d, 4); d += __shfl_xor(d, 8);
          if (mode) {
            const int t = qi >> 1, g = qi & 1;
            const int rel = t + 128 - key;
            const float slope = exp2f(-2.f * (float)(hh * 2 + g + 1));
            d = (rel >= 0 && rel <= 128) ? d - slope * (float)rel : -1e30f;
          }
          if (dl == 0 && key < nkeys) sc[key * 8 + qi] = d;
        }
      }
    }
  }
  __syncthreads();
  float o[8];
#pragma unroll
  for (int qi = 0; qi < 8; qi++) o[qi] = 0.f;
  for (int k0 = 0; k0 < nkeys; k0 += NV * 4) {
    float vvs[NV];
#pragma unroll
    for (int u = 0; u < NV; u++) {
      const int key = k0 + u * 4 + w;
      float vv = 0.f;
      if (key < nkeys) {
        if (mode) {
          if (key < 128) vv = ldnt1(p.cache_swa_v + (((size_t)l * 128 + sb) * 128 + key) * 128 + hh * 64 + lane);
          else vv = b2f(proj[(size_t)(rowbase + key - 128) * DIN + C_AV + hh * 64 + lane]);
        } else {
          vv = ldnt1(p.cache_mem_v + (((size_t)l * 128 + sb) * 256 + key) * 256 + hh * 64 + lane);
        }
      }
      vvs[u] = vv;
    }
    if (k0 == 0) {
      for (int qi = w; qi < nq; qi += 4) {
        float mx = -1e30f;
        for (int k = lane; k < nkeys; k += 64) mx = fmaxf(mx, sc[k * 8 + qi]);
        mx = wmaxf(mx);
        float sinkv = 0.f;
        if (mode) { sinkv = p.attn_sink[l * 4 + hh * 2 + (qi & 1)]; mx = fmaxf(mx, sinkv); }
        float sum = 0.f;
        for (int k = lane; k < nkeys; k += 64) { float e = __expf(sc[k * 8 + qi] - mx); sc[k * 8 + qi] = e; sum += e; }
        sum = wsum(sum);
        if (mode) sum += __expf(sinkv - mx);
        if (lane == 0) rinv[qi] = 1.f / sum;
      }
      __syncthreads();
    }
#pragma unroll
    for (int u = 0; u < NV; u++) {
      const int key = k0 + u * 4 + w;
      if (key < nkeys) {
        const float vv = vvs[u];
        const float4 p0 = *(const float4*)(sc + key * 8);
        const float4 p1 = *(const float4*)(sc + key * 8 + 4);
        o[0] += p0.x * vv; o[1] += p0.y * vv; o[2] += p0.z * vv; o[3] += p0.w * vv;
        o[4] += p1.x * vv; o[5] += p1.y * vv; o[6] += p1.z * vv; o[7] += p1.w * vv;
      }
    }
  }
#pragma unroll
  for (int qi = 0; qi < 8; qi++) red[(w * 8 + qi) * 64 + lane] = o[qi];
  __syncthreads();
  for (int e = tid; e < nq * 64; e += 256) {
    int qi = e >> 6, d = e & 63;
    float v = (red[(0 * 8 + qi) * 64 + d] + red[(1 * 8 + qi) * 64 + d] + red[(2 * 8 + qi) * 64 + d] + red[(3 * 8 + qi) * 64 + d]) * rinv[qi];
    if (mode) {
      int t = qi >> 1, g = qi & 1;
      ((u16*)(p.ws + WS_MIX))[(size_t)(rowbase + t) * 1024 + (hh * 2 + g) * 64 + d] = f2b(v);
    } else {
      ((u16*)(p.ws + WS_OX))[(size_t)(rowbase + qi) * 256 + hh * 64 + d] = f2b(v);
    }
  }
}

using f32x2 = __attribute__((ext_vector_type(2))) float;
constexpr int HSUB = 32;
template <bool WANT_O, bool WANT_D>
DEVI void hgrn_item(const Params& p, int l, int row0, int ntok, int h, const float* __restrict__ Sinit, float* __restrict__ Sout,
                    float* __restrict__ Dout, char* smem) {
  float* sk = (float*)smem;
  float* sq = sk + HSUB * 64;
  float* sv = sq + HSUB * 64;
  float* sop = sv + HSUB * 64;
  const int tid = tidx(), lane = tid & 63, kq = tid >> 6;
  const u16* proj = (const u16*)(p.ws + WS_PROJ);
  f32x2 S[8], Dacc[8];
#pragma unroll
  for (int i = 0; i < 8; i++) {
    S[i][0] = Sinit ? Sinit[(kq * 16 + 2 * i) * 64 + lane] : 0.f;
    S[i][1] = Sinit ? Sinit[(kq * 16 + 2 * i + 1) * 64 + lane] : 0.f;
    Dacc[i] = (f32x2){1.f, 1.f};
  }
  const int col = h * 64 + lane;
  float lb;
  {
    float a0 = p.hgrn_lb[col], a1 = p.hgrn_lb[256 + col], a2 = p.hgrn_lb[512 + col], a3 = p.hgrn_lb[768 + col];
    float m = fmaxf(fmaxf(a0, a1), fmaxf(a2, a3));
    float e0 = __expf(a0 - m), e1 = __expf(a1 - m), e2 = __expf(a2 - m), e3 = __expf(a3 - m);
    float z = 1.f / (e0 + e1 + e2 + e3);
    lb = (l == 0) ? 0.f : (l == 1) ? e1 * z : (l == 2) ? (e1 + e2) * z : (e1 + e2 + e3) * z;
  }
  constexpr int NST = HSUB / 4;
  u16 rq[NST], rf[NST], ri[NST];
#pragma unroll
  for (int i = 0; i < NST; i++) {
    const int tt = kq + 4 * i;
    rq[i] = 0; rf[i] = 0; ri[i] = 0;
    if (tt < ntok) {
      const u16* pr = proj + (size_t)(row0 + tt) * DIN;
      if (WANT_O) rq[i] = pr[C_BQ + col];
      rf[i] = pr[C_BF + col]; ri[i] = pr[C_BI + col];
    }
  }
  for (int t0 = 0; t0 < ntok; t0 += HSUB) {
    const int nt = min(HSUB, ntok - t0);
    __syncthreads();
#pragma unroll
    for (int i = 0; i < NST; i++) {
      const int tt = kq + 4 * i;
      if (tt < nt) {
        float fp = b2f(rf[i]);
        fp = fminf(fmaxf(fp, -30.f), 30.f);
        float e = __expf(-fp);
        float sg = __builtin_amdgcn_rcpf(1.f + e);
        float sgn = e * sg;
        sk[tt * 64 + lane] = (1.f - lb) * sgn;
        if (WANT_O) sq[tt * 64 + lane] = siluf_(b2f(rq[i]));
        sv[tt * 64 + lane] = b2f(ri[i]);
      }
    }
    if (t0 + HSUB < ntok) {
#pragma unroll
      for (int i = 0; i < NST; i++) {
        const int tt = t0 + HSUB + kq + 4 * i;
        if (tt < ntok) {
          const u16* pr = proj + (size_t)(row0 + tt) * DIN;
          if (WANT_O) rq[i] = pr[C_BQ + col];
          rf[i] = pr[C_BF + col]; ri[i] = pr[C_BI + col];
        }
      }
    }
    __syncthreads();
    const int ett = tid >> 4, ev4 = (tid & 15) * 4;
    float4 e_ng = make_float4(0, 0, 0, 0);
    uint2 e_gu[HSUB / 16];
#pragma unroll
    for (int ps = 0; ps < HSUB / 16; ps++) e_gu[ps] = make_uint2(0u, 0u);
    if (WANT_O) {
      e_ng = *(const float4*)(p.hgrn_norm_g + l * 256 + h * 64 + ev4);
#pragma unroll
      for (int ps = 0; ps < HSUB / 16; ps++)
        if (ps * 16 + ett < nt) e_gu[ps] = *(const uint2*)(proj + (size_t)(row0 + t0 + ps * 16 + ett) * DIN + C_BG + h * 64 + ev4);
    }
#pragma unroll 4
    for (int tt = 0; tt < nt; tt++) {
      const float vv = sv[tt * 64 + lane];
      const f32x2 vv2 = {vv, vv};
      f32x2 o2 = {0.f, 0.f};
#pragma unroll
      for (int i4 = 0; i4 < 4; i4++) {
        const f32x4 k4 = *(const f32x4*)(sk + tt * 64 + kq * 16 + i4 * 4);
        const f32x2 ka = {k4[0], k4[1]}, kb = {k4[2], k4[3]};
        S[i4 * 2] = S[i4 * 2] + ka * (vv2 - S[i4 * 2]);
        S[i4 * 2 + 1] = S[i4 * 2 + 1] + kb * (vv2 - S[i4 * 2 + 1]);
        if (WANT_D) { Dacc[i4 * 2] *= ((f32x2){1.f, 1.f} - ka); Dacc[i4 * 2 + 1] *= ((f32x2){1.f, 1.f} - kb); }
        if (WANT_O) {
          const f32x4 q4 = *(const f32x4*)(sq + tt * 64 + kq * 16 + i4 * 4);
          const f32x2 qa = {q4[0], q4[1]}, qb = {q4[2], q4[3]};
          o2 += qa * S[i4 * 2];
          o2 += qb * S[i4 * 2 + 1];
        }
      }
      if (WANT_O) sop[(kq * HSUB + tt) * 64 + lane] = o2[0] + o2[1];
    }
    if (WANT_O) {
      __syncthreads();
#pragma unroll
      for (int ps = 0; ps < HSUB / 16; ps++) {
        const int tt = ps * 16 + ett, v4 = ev4;
        const bool act = tt < nt;
        float4 o4 = make_float4(0, 0, 0, 0);
        if (act) {
#pragma unroll
          for (int k4 = 0; k4 < 4; k4++) {
            const float4 x = *(const float4*)(sop + (k4 * HSUB + tt) * 64 + v4);
            o4.x += x.x; o4.y += x.y; o4.z += x.z; o4.w += x.w;
          }
        }
        float ss = o4.x * o4.x + o4.y * o4.y + o4.z * o4.z + o4.w * o4.w;
        ss += __shfl_xor(ss, 1); ss += __shfl_xor(ss, 2); ss += __shfl_xor(ss, 4); ss += __shfl_xor(ss, 8);
        if (act) {
          const float rs = rsqrtf(ss * (1.f / 64.f) + 1e-6f);
          const int row = row0 + t0 + tt;
          const float4 ng = e_ng;
          const uint2 gu = e_gu[ps];
          uint2 pk;
          pk.x = pack2(o4.x * rs * ng.x * siluf_(blo(gu.x)), o4.y * rs * ng.y * siluf_(bhi(gu.x)));
          pk.y = pack2(o4.z * rs * ng.z * siluf_(blo(gu.y)), o4.w * rs * ng.w * siluf_(bhi(gu.y)));
          *(uint2*)((u16*)(p.ws + WS_MIX) + (size_t)row * 1024 + 256 + h * 64 + v4) = pk;
        }
      }
    }
  }
  if (Sout) {
#pragma unroll
    for (int i = 0; i < 8; i++) {
      Sout[(kq * 16 + 2 * i) * 64 + lane] = S[i][0];
      Sout[(kq * 16 + 2 * i + 1) * 64 + lane] = S[i][1];
    }
  }
  if (WANT_D) {
    if (Dout && lane == 0) {
#pragma unroll
      for (int i = 0; i < 8; i++) { Dout[kq * 16 + 2 * i] = Dacc[i][0]; Dout[kq * 16 + 2 * i + 1] = Dacc[i][1]; }
    }
  }
}

using bf16x4 = __attribute__((ext_vector_type(4))) short;
template <bool WANT_O>
DEVI void hgrn_mfma_item(const Params& p, int l, int row0, int h, const float* __restrict__ Sinit, float* __restrict__ Uout,
                         float* __restrict__ Dout, char* smem) {
  float* LF = (float*)smem;
  u16* KKb = (u16*)(smem + 16384);
  u16* Qb = (u16*)(smem + 24576);
  u16* VT = (u16*)(smem + 32768);
  u16* QH = (u16*)(smem + 41984);
  u16* KH = (u16*)(smem + 44288);
  u16* KTT = (u16*)(smem + 46592);
  u16* ST = (u16*)(smem + 48640);
  float* RED = (float*)(smem + 57856);
  const int tid = tidx(), lane = tid & 63, w = tid >> 6, r16 = lane & 15, quad = lane >> 4;
  const u16* proj = (const u16*)(p.ws + WS_PROJ);
  const int col = h * 64 + (tid & 63);
  float lb;
  {
    float a0 = p.hgrn_lb[col], a1 = p.hgrn_lb[256 + col], a2 = p.hgrn_lb[512 + col], a3 = p.hgrn_lb[768 + col];
    float m = fmaxf(fmaxf(a0, a1), fmaxf(a2, a3));
    float e0 = __expf(a0 - m), e1 = __expf(a1 - m), e2 = __expf(a2 - m), e3 = __expf(a3 - m);
    float z = 1.f / (e0 + e1 + e2 + e3);
    lb = (l == 0) ? 0.f : (l == 1) ? e1 * z : (l == 2) ? (e1 + e2) * z : (e1 + e2 + e3) * z;
  }
  f32x4 S[4];
#pragma unroll
  for (int nf = 0; nf < 4; nf++) {
    if (Sinit) S[nf] = *(const f32x4*)(Sinit + (size_t)(nf * 16 + r16) * 64 + 16 * w + quad * 4);
    else S[nf] = (f32x4){0.f, 0.f, 0.f, 0.f};
  }
  __syncthreads();
#pragma unroll
  for (int g4 = 0; g4 < 4; g4++) {
    u16 rq[4], rf[4], ri[4];
#pragma unroll
    for (int i = 0; i < 4; i++) {
      const int tt = w + 4 * (g4 * 4 + i);
      const u16* pr = proj + (size_t)(row0 + tt) * DIN;
      rq[i] = WANT_O ? pr[C_BQ + col] : (u16)0;
      rf[i] = pr[C_BF + col]; ri[i] = pr[C_BI + col];
    }
#pragma unroll
    for (int i = 0; i < 4; i++) {
      const int tt = w + 4 * (g4 * 4 + i);
      float fp = fminf(fmaxf(b2f(rf[i]), -30.f), 30.f);
      const float e = __expf(-fp);
      const float sg = __builtin_amdgcn_rcpf(1.f + e);
      const float kk = (1.f - lb) * e * sg;
      LF[tt * 64 + (tid & 63)] = __logf(fmaxf(1.f - kk, 1e-30f));
      KKb[tt * 64 + (tid & 63)] = f2b(kk);
      if (WANT_O) Qb[tt * 64 + (tid & 63)] = f2b(siluf_(b2f(rq[i])));
      VT[(tid & 63) * 72 + tt] = ri[i];
    }
  }
  if (WANT_O) {
#pragma unroll
    for (int nf = 0; nf < 4; nf++)
#pragma unroll
      for (int jj = 0; jj < 4; jj++) ST[(16 * w + quad * 4 + jj) * 72 + nf * 16 + r16] = f2b(S[nf][jj]);
  }
  __syncthreads();
  {
    const int k = tid & 63, i = tid >> 6;
    float run = 0.f;
#pragma unroll
    for (int tt = 0; tt < 16; tt++) { run += LF[(16 * i + tt) * 64 + k]; LF[(16 * i + tt) * 64 + k] = run; }
    __syncthreads();
    float off = 0.f;
    if (i >= 1) off += LF[15 * 64 + k];
    if (i >= 2) off += LF[31 * 64 + k];
    if (i >= 3) off += LF[47 * 64 + k];
    __syncthreads();
    if (i >= 1) {
#pragma unroll
      for (int tt = 0; tt < 16; tt++) LF[(16 * i + tt) * 64 + k] += off;
    }
    __syncthreads();
  }
  float4 ng = make_float4(0, 0, 0, 0);
  if (WANT_O) ng = *(const float4*)(p.hgrn_norm_g + l * 256 + h * 64 + 16 * w + quad * 4);
  for (int i = 0; i < 4; i++) {
    uint2 gu = make_uint2(0u, 0u);
    if (WANT_O) gu = *(const uint2*)(proj + (size_t)(row0 + 16 * i + r16) * DIN + C_BG + h * 64 + 16 * w + quad * 4);
    {
      const int t = tid >> 4, k4 = (tid & 15) * 4;
      const f32x4 ct = *(const f32x4*)(LF + (16 * i + t) * 64 + k4);
      f32x4 bi = {0.f, 0.f, 0.f, 0.f};
      if (i > 0) bi = *(const f32x4*)(LF + (16 * i - 1) * 64 + k4);
      const f32x4 bn = *(const f32x4*)(LF + (16 * i + 15) * 64 + k4);
      const u32x2 kr = *(const u32x2*)(KKb + (16 * i + t) * 64 + k4);
      const float kk0 = blo(kr[0]), kk1 = bhi(kr[0]), kk2 = blo(kr[1]), kk3 = bhi(kr[1]);
      KTT[(k4 + 0) * 16 + t] = f2b(kk0 * __expf(bn[0] - ct[0]));
      KTT[(k4 + 1) * 16 + t] = f2b(kk1 * __expf(bn[1] - ct[1]));
      KTT[(k4 + 2) * 16 + t] = f2b(kk2 * __expf(bn[2] - ct[2]));
      KTT[(k4 + 3) * 16 + t] = f2b(kk3 * __expf(bn[3] - ct[3]));
      if (WANT_O) {
        const u32x2 qr = *(const u32x2*)(Qb + (16 * i + t) * 64 + k4);
        u32x2 qo, ko;
        qo[0] = pack2(blo(qr[0]) * __expf(ct[0] - bi[0]), bhi(qr[0]) * __expf(ct[1] - bi[1]));
        qo[1] = pack2(blo(qr[1]) * __expf(ct[2] - bi[2]), bhi(qr[1]) * __expf(ct[3] - bi[3]));
        ko[0] = pack2(kk0 * __expf(fminf(bi[0] - ct[0], 60.f)), kk1 * __expf(fminf(bi[1] - ct[1], 60.f)));
        ko[1] = pack2(kk2 * __expf(fminf(bi[2] - ct[2], 60.f)), kk3 * __expf(fminf(bi[3] - ct[3], 60.f)));
        *(u32x2*)(QH + t * 72 + k4) = qo;
        *(u32x2*)(KH + t * 72 + k4) = ko;
      }
    }
    __syncthreads();
    const bf16x4 vf = *(const bf16x4*)(VT + (16 * w + r16) * 72 + 16 * i + quad * 4);
    f32x4 oacc = {0.f, 0.f, 0.f, 0.f};
    if (WANT_O) {
      bf16x8 qf[2], kf[2], sf[2];
#pragma unroll
      for (int ks = 0; ks < 2; ks++) {
        qf[ks] = *(const bf16x8*)(QH + r16 * 72 + ks * 32 + quad * 8);
        kf[ks] = *(const bf16x8*)(KH + r16 * 72 + ks * 32 + quad * 8);
        sf[ks] = *(const bf16x8*)(ST + (16 * w + r16) * 72 + ks * 32 + quad * 8);
      }
      f32x4 at = {0.f, 0.f, 0.f, 0.f};
      at = __builtin_amdgcn_mfma_f32_16x16x32_bf16(kf[0], qf[0], at, 0, 0, 0);
      at = __builtin_amdgcn_mfma_f32_16x16x32_bf16(kf[1], qf[1], at, 0, 0, 0);
      oacc = __builtin_amdgcn_mfma_f32_16x16x32_bf16(sf[0], qf[0], oacc, 0, 0, 0);
      oacc = __builtin_amdgcn_mfma_f32_16x16x32_bf16(sf[1], qf[1], oacc, 0, 0, 0);
      u32x2 pau;
      pau[0] = pack2((quad * 4 + 0 <= r16) ? at[0] : 0.f, (quad * 4 + 1 <= r16) ? at[1] : 0.f);
      pau[1] = pack2((quad * 4 + 2 <= r16) ? at[2] : 0.f, (quad * 4 + 3 <= r16) ? at[3] : 0.f);
      oacc = __builtin_amdgcn_mfma_f32_16x16x16bf16_1k(vf, __builtin_bit_cast(bf16x4, pau), oacc, 0, 0, 0);
    }
#pragma unroll
    for (int nf = 0; nf < 4; nf++) {
      const int k = nf * 16 + r16;
      const float bnk = LF[(16 * i + 15) * 64 + k];
      const float bik = (i > 0) ? LF[(16 * i - 1) * 64 + k] : 0.f;
      const float d = __expf(bnk - bik);
      const bf16x4 kt = *(const bf16x4*)(KTT + k * 16 + quad * 4);
      f32x4 sc = S[nf];
      sc[0] *= d; sc[1] *= d; sc[2] *= d; sc[3] *= d;
      S[nf] = __builtin_amdgcn_mfma_f32_16x16x16bf16_1k(vf, kt, sc, 0, 0, 0);
    }
    if (WANT_O) {
      if (i < 3) {
#pragma unroll
        for (int nf = 0; nf < 4; nf++)
#pragma unroll
          for (int jj = 0; jj < 4; jj++) ST[(16 * w + quad * 4 + jj) * 72 + nf * 16 + r16] = f2b(S[nf][jj]);
      }
      float ss = oacc[0] * oacc[0] + oacc[1] * oacc[1] + oacc[2] * oacc[2] + oacc[3] * oacc[3];
      ss += __shfl_xor(ss, 16); ss += __shfl_xor(ss, 32);
      if (quad == 0) RED[w * 16 + r16] = ss;
      __syncthreads();
      const float tot = RED[r16] + RED[16 + r16] + RED[32 + r16] + RED[48 + r16];
      const float rs = rsqrtf(tot * (1.f / 64.f) + 1e-6f);
      uint2 pk;
      pk.x = pack2(oacc[0] * rs * ng.x * siluf_(blo(gu.x)), oacc[1] * rs * ng.y * siluf_(bhi(gu.x)));
      pk.y = pack2(oacc[2] * rs * ng.z * siluf_(blo(gu.y)), oacc[3] * rs * ng.w * siluf_(bhi(gu.y)));
      *(uint2*)((u16*)(p.ws + WS_MIX) + (size_t)(row0 + 16 * i + r16) * 1024 + 256 + h * 64 + 16 * w + quad * 4) = pk;
    }
    __syncthreads();
  }
  if (Uout) {
#pragma unroll
    for (int nf = 0; nf < 4; nf++) *(f32x4*)(Uout + (size_t)(nf * 16 + r16) * 64 + 16 * w + quad * 4) = S[nf];
  }
  if (Dout && tid < 64) Dout[tid] = __expf(LF[63 * 64 + tid]);
}

DEVI void convpool_item(const Params& p, int l, int r0) {
  const int tid = tidx();
  const int cj = tid & 63;
  const u16* proj = (const u16*)(p.ws + WS_PROJ);
  for (int rr = tid >> 6; rr < 16; rr += 4) {
    const int r = r0 + rr;
    const bool isS = r >= T_P;
    const int seq = isS ? (r - T_P) >> 2 : r >> 11;
    const int t = isS ? (r - T_P) & 3 : r & 2047;
    const int Tn = isS ? 4 : 2048;
    const u16* pr = proj + (size_t)r * DIN;
    if (cj < 32) {
      const int j0 = cj * 8;
      float cb[8], u0[8], u1[8], u2[8], a[8], b[8];
      unpack8(*(const uint4*)(pr + C_CB + j0), cb);
      unpack8(*(const uint4*)(pr + C_CC + j0), a);
      unpack8(*(const uint4*)(pr + C_CH + j0), b);
#pragma unroll
      for (int i = 0; i < 8; i++) u0[i] = a[i] * b[i];
      if (t >= 1) {
        unpack8(*(const uint4*)(pr - DIN + C_CC + j0), a);
        unpack8(*(const uint4*)(pr - DIN + C_CH + j0), b);
#pragma unroll
        for (int i = 0; i < 8; i++) u1[i] = a[i] * b[i];
      } else if (isS) {
        const float* sp = p.state_conv + (((size_t)l * 128 + seq) * 2 + 1) * 256 + j0;
#pragma unroll
        for (int i = 0; i < 8; i++) u1[i] = sp[i];
      } else {
#pragma unroll
        for (int i = 0; i < 8; i++) u1[i] = 0.f;
      }
      if (t >= 2) {
        unpack8(*(const uint4*)(pr - 2 * DIN + C_CC + j0), a);
        unpack8(*(const uint4*)(pr - 2 * DIN + C_CH + j0), b);
#pragma unroll
        for (int i = 0; i < 8; i++) u2[i] = a[i] * b[i];
      } else if (isS) {
        const float* sp = p.state_conv + (((size_t)l * 128 + seq) * 2 + t) * 256 + j0;
#pragma unroll
        for (int i = 0; i < 8; i++) u2[i] = sp[i];
      } else {
#pragma unroll
        for (int i = 0; i < 8; i++) u2[i] = 0.f;
      }
      const float* cw = p.conv_w + (size_t)l * 3 * 256 + j0;
      float y[8];
#pragma unroll
      for (int i = 0; i < 8; i++) y[i] = cb[i] * (cw[i] * u2[i] + cw[256 + i] * u1[i] + cw[512 + i] * u0[i]);
      uint4 o;
      o.x = pack2(y[0], y[1]); o.y = pack2(y[2], y[3]); o.z = pack2(y[4], y[5]); o.w = pack2(y[6], y[7]);
      *(uint4*)((u16*)(p.ws + WS_MIX) + (size_t)r * 1024 + 512 + j0) = o;
      if (isS && t == Tn - 1) {
        float* dst = isS ? p.out + O_CONV_S + (((size_t)l * 128 + seq) * 2) * 256 + j0
                         : p.out + O_CONV_P + (((size_t)l * 8 + seq) * 2) * 256 + j0;
#pragma unroll
        for (int i = 0; i < 8; i++) { dst[i] = u1[i]; dst[256 + i] = u0[i]; }
      }
    } else {
      const int c0 = (cj - 32) * 8;
      const int g = (cj - 32) >> 3;
      const int wdw = 2 << g;
      float sum[8], v0[8], tmp[8];
      unpack8(*(const uint4*)(pr + C_DV + c0), v0);
#pragma unroll
      for (int i = 0; i < 8; i++) sum[i] = v0[i];
      if (!isS) {
        uint4 raw[15];
#pragma unroll
        for (int jj = 1; jj < 16; jj++)
          raw[jj - 1] = (jj < wdw && t - jj >= 0) ? *(const uint4*)(pr - (ptrdiff_t)jj * DIN + C_DV + c0) : make_uint4(0u, 0u, 0u, 0u);
#pragma unroll
        for (int jj = 1; jj < 16; jj++) {
          unpack8(raw[jj - 1], tmp);
#pragma unroll
          for (int i = 0; i < 8; i++) sum[i] += tmp[i];
        }
      } else {
        for (int jj = 1; jj < wdw; jj++) {
          const int tp = t - jj;
          if (tp >= 0) {
            unpack8(*(const uint4*)(pr - (size_t)jj * DIN + C_DV + c0), tmp);
#pragma unroll
            for (int i = 0; i < 8; i++) sum[i] += tmp[i];
          } else {
            const float* sp = p.state_pool + (((size_t)l * 128 + seq) * 15 + 15 + tp) * 256 + c0;
#pragma unroll
            for (int i = 0; i < 8; i++) sum[i] += sp[i];
          }
        }
      }
      const float cnt = isS ? (float)wdw : (float)min(t + 1, wdw);
      const float ic = 1.f / cnt;
      float y[8];
#pragma unroll
      for (int i = 0; i < 8; i++) y[i] = sum[i] * ic - v0[i];
      uint4 o;
      o.x = pack2(y[0], y[1]); o.y = pack2(y[2], y[3]); o.z = pack2(y[4], y[5]); o.w = pack2(y[6], y[7]);
      *(uint4*)((u16*)(p.ws + WS_POOLED) + (size_t)r * 256 + c0) = o;
      if (isS && t == Tn - 1) {
        for (int i15 = 0; i15 < 15; i15++) {
          float val[8];
          if (!isS) {
            unpack8(*(const uint4*)(pr - (size_t)(14 - i15) * DIN + C_DV + c0), val);
          } else {
            const int tp = i15 - 11;
            if (tp < 0) {
              const float* sp = p.state_pool + (((size_t)l * 128 + seq) * 15 + 4 + i15) * 256 + c0;
#pragma unroll
              for (int i = 0; i < 8; i++) val[i] = sp[i];
            } else {
              unpack8(*(const uint4*)(pr - (size_t)(3 - tp) * DIN + C_DV + c0), val);
            }
          }
          float* dst = isS ? p.out + O_POOL_S + (((size_t)l * 128 + seq) * 15 + i15) * 256 + c0
                           : p.out + O_POOL_P + (((size_t)l * 8 + seq) * 15 + i15) * 256 + c0;
#pragma unroll
          for (int i = 0; i < 8; i++) dst[i] = val[i];
        }
      }
    }
  }
}

DEVI void convpool_fast(const Params& p, int l, int r0) {
  const int tid = tidx();
  const int h2 = tid >> 7, cc = tid & 127;
  const u16* proj = (const u16*)(p.ws + WS_PROJ);
  const int rs = r0 + h2 * 8;
  const int ts = rs & 2047;
  if (cc < 64) {
    const int j0 = cc * 4;
    u32x2 rc[10], rh[10], rb[8];
#pragma unroll
    for (int i = 0; i < 10; i++) {
      const bool ok = (ts + i - 2) >= 0;
      const u16* pr = proj + (ptrdiff_t)(rs + i - 2) * DIN;
      rc[i] = ok ? *(const u32x2*)(pr + C_CC + j0) : (u32x2){0u, 0u};
      rh[i] = ok ? *(const u32x2*)(pr + C_CH + j0) : (u32x2){0u, 0u};
    }
#pragma unroll
    for (int i = 0; i < 8; i++) rb[i] = *(const u32x2*)(proj + (size_t)(rs + i) * DIN + C_CB + j0);
    const float4 w0 = *(const float4*)(p.conv_w + (size_t)l * 768 + j0);
    const float4 w1 = *(const float4*)(p.conv_w + (size_t)l * 768 + 256 + j0);
    const float4 w2 = *(const float4*)(p.conv_w + (size_t)l * 768 + 512 + j0);
    float u[10][4];
#pragma unroll
    for (int i = 0; i < 10; i++) {
      u[i][0] = blo(rc[i][0]) * blo(rh[i][0]); u[i][1] = bhi(rc[i][0]) * bhi(rh[i][0]);
      u[i][2] = blo(rc[i][1]) * blo(rh[i][1]); u[i][3] = bhi(rc[i][1]) * bhi(rh[i][1]);
    }
#pragma unroll
    for (int i = 0; i < 8; i++) {
      const float y0 = blo(rb[i][0]) * (w0.x * u[i][0] + w1.x * u[i + 1][0] + w2.x * u[i + 2][0]);
      const float y1 = bhi(rb[i][0]) * (w0.y * u[i][1] + w1.y * u[i + 1][1] + w2.y * u[i + 2][1]);
      const float y2 = blo(rb[i][1]) * (w0.z * u[i][2] + w1.z * u[i + 1][2] + w2.z * u[i + 2][2]);
      const float y3 = bhi(rb[i][1]) * (w0.w * u[i][3] + w1.w * u[i + 1][3] + w2.w * u[i + 2][3]);
      u32x2 o; o[0] = pack2(y0, y1); o[1] = pack2(y2, y3);
      *(u32x2*)((u16*)(p.ws + WS_MIX) + (size_t)(rs + i) * 1024 + 512 + j0) = o;
    }
  } else {
    const int c0 = (cc - 64) * 4;
    const int g = c0 >> 6;
    const int wdw = 2 << g;
    u32x2 rv[23];
#pragma unroll
    for (int i = 0; i < 23; i++) {
      const bool ok = (i >= 16 - wdw) && (ts + i - 15) >= 0;
      rv[i] = ok ? *(const u32x2*)(proj + (ptrdiff_t)(rs + i - 15) * DIN + C_DV + c0) : (u32x2){0u, 0u};
    }
    float v[23][4];
#pragma unroll
    for (int i = 0; i < 23; i++) { v[i][0] = blo(rv[i][0]); v[i][1] = bhi(rv[i][0]); v[i][2] = blo(rv[i][1]); v[i][3] = bhi(rv[i][1]); }
#pragma unroll
    for (int i = 0; i < 8; i++) {
      float s0 = 0.f, s1 = 0.f, s2 = 0.f, s3 = 0.f;
#pragma unroll
      for (int jj = 0; jj < 16; jj++) {
        if (jj < wdw) { s0 += v[15 + i - jj][0]; s1 += v[15 + i - jj][1]; s2 += v[15 + i - jj][2]; s3 += v[15 + i - jj][3]; }
      }
      const float ic = 1.f / (float)min(ts + i + 1, wdw);
      u32x2 o;
      o[0] = pack2(s0 * ic - v[15 + i][0], s1 * ic - v[15 + i][1]);
      o[1] = pack2(s2 * ic - v[15 + i][2], s3 * ic - v[15 + i][3]);
      *(u32x2*)((u16*)(p.ws + WS_POOLED) + (size_t)(rs + i) * 256 + c0) = o;
    }
  }
}

DEVI void convpool_sample(const Params& p, int l, int sb) {
  const int tid = tidx();
  const int t = tid >> 6, cj = tid & 63;
  const u16* proj = (const u16*)(p.ws + WS_PROJ);
  const int r = T_P + sb * 4 + t;
  const u16* pr = proj + (size_t)r * DIN;
  if (cj < 32) {
    const int j0 = cj * 8;
    float cb[8], u0[8], u1[8], u2[8], a[8], b[8];
    unpack8(*(const uint4*)(pr + C_CB + j0), cb);
    unpack8(*(const uint4*)(pr + C_CC + j0), a);
    unpack8(*(const uint4*)(pr + C_CH + j0), b);
#pragma unroll
    for (int i = 0; i < 8; i++) u0[i] = a[i] * b[i];
    if (t >= 1) {
      unpack8(*(const uint4*)(pr - DIN + C_CC + j0), a);
      unpack8(*(const uint4*)(pr - DIN + C_CH + j0), b);
#pragma unroll
      for (int i = 0; i < 8; i++) u1[i] = a[i] * b[i];
    } else {
      const float* sp = p.state_conv + (((size_t)l * 128 + sb) * 2 + 1) * 256 + j0;
      const float4 s0 = *(const float4*)sp, s1 = *(const float4*)(sp + 4);
      u1[0] = s0.x; u1[1] = s0.y; u1[2] = s0.z; u1[3] = s0.w; u1[4] = s1.x; u1[5] = s1.y; u1[6] = s1.z; u1[7] = s1.w;
    }
    if (t >= 2) {
      unpack8(*(const uint4*)(pr - 2 * DIN + C_CC + j0), a);
      unpack8(*(const uint4*)(pr - 2 * DIN + C_CH + j0), b);
#pragma unroll
      for (int i = 0; i < 8; i++) u2[i] = a[i] * b[i];
    } else {
      const float* sp = p.state_conv + (((size_t)l * 128 + sb) * 2 + t) * 256 + j0;
      const float4 s0 = *(const float4*)sp, s1 = *(const float4*)(sp + 4);
      u2[0] = s0.x; u2[1] = s0.y; u2[2] = s0.z; u2[3] = s0.w; u2[4] = s1.x; u2[5] = s1.y; u2[6] = s1.z; u2[7] = s1.w;
    }
    const float* cw = p.conv_w + (size_t)l * 768 + j0;
    float y[8];
#pragma unroll
    for (int i = 0; i < 8; i++) y[i] = cb[i] * (cw[i] * u2[i] + cw[256 + i] * u1[i] + cw[512 + i] * u0[i]);
    uint4 o;
    o.x = pack2(y[0], y[1]); o.y = pack2(y[2], y[3]); o.z = pack2(y[4], y[5]); o.w = pack2(y[6], y[7]);
    *(uint4*)((u16*)(p.ws + WS_MIX) + (size_t)r * 1024 + 512 + j0) = o;
    if (t == 3) {
      float* dst = p.out + O_CONV_S + (((size_t)l * 128 + sb) * 2) * 256 + j0;
#pragma unroll
      for (int i = 0; i < 8; i++) { dst[i] = u1[i]; dst[256 + i] = u0[i]; }
    }
  } else {
    const int c0 = (cj - 32) * 8;
    const int g = (cj - 32) >> 3;
    const int wdw = 2 << g;
    const float* spool = p.state_pool + ((size_t)l * 128 + sb) * 15 * 256 + c0;
    float sum[8], v0[8];
    unpack8(*(const uint4*)(pr + C_DV + c0), v0);
#pragma unroll
    for (int i = 0; i < 8; i++) sum[i] = v0[i];
#pragma unroll
    for (int jj = 1; jj < 16; jj++) {
      if (jj < wdw) {
        const int tp = t - jj;
        if (tp >= 0) {
          float tmp[8];
          unpack8(*(const uint4*)(pr - (ptrdiff_t)jj * DIN + C_DV + c0), tmp);
#pragma unroll
          for (int i = 0; i < 8; i++) sum[i] += tmp[i];
        } else {
          const float4 s0 = *(const float4*)(spool + (size_t)(15 + tp) * 256), s1 = *(const float4*)(spool + (size_t)(15 + tp) * 256 + 4);
          sum[0] += s0.x; sum[1] += s0.y; sum[2] += s0.z; sum[3] += s0.w; sum[4] += s1.x; sum[5] += s1.y; sum[6] += s1.z; sum[7] += s1.w;
        }
      }
    }
    const float ic = 1.f / (float)wdw;
    float y[8];
#pragma unroll
    for (int i = 0; i < 8; i++) y[i] = sum[i] * ic - v0[i];
    uint4 o;
    o.x = pack2(y[0], y[1]); o.y = pack2(y[2], y[3]); o.z = pack2(y[4], y[5]); o.w = pack2(y[6], y[7]);
    *(uint4*)((u16*)(p.ws + WS_POOLED) + (size_t)r * 256 + c0) = o;
    if (t == 3) {
      float* dstb = p.out + O_POOL_S + ((size_t)l * 128 + sb) * 15 * 256 + c0;
#pragma unroll
      for (int i15 = 0; i15 < 15; i15++) {
        float val[8];
        if (i15 < 11) {
          const float4 s0 = *(const float4*)(spool + (size_t)(4 + i15) * 256), s1 = *(const float4*)(spool + (size_t)(4 + i15) * 256 + 4);
          val[0] = s0.x; val[1] = s0.y; val[2] = s0.z; val[3] = s0.w; val[4] = s1.x; val[5] = s1.y; val[6] = s1.z; val[7] = s1.w;
        } else {
          unpack8(*(const uint4*)(pr - (ptrdiff_t)(14 - i15) * DIN + C_DV + c0), val);
        }
        float* dst = dstb + (size_t)i15 * 256;
        *(float4*)dst = make_float4(val[0], val[1], val[2], val[3]);
        *(float4*)(dst + 4) = make_float4(val[4], val[5], val[6], val[7]);
      }
    }
  }
}

DEVI void prompt_state_item(const Params& p, int l, int item) {
  const u16* proj = (const u16*)(p.ws + WS_PROJ);
  const int e = item * 256 + tidx();
  if (e >= 8 * 17 * 32) return;
  const int c8 = e & 31, rr = (e >> 5) % 17, b = (e >> 5) / 17;
  const int j0 = c8 * 8;
  if (rr < 2) {
    const u16* pr = proj + (size_t)(b * 2048 + 2046 + rr) * DIN;
    float a[8], c[8];
    unpack8(*(const uint4*)(pr + C_CC + j0), a);
    unpack8(*(const uint4*)(pr + C_CH + j0), c);
    float* dst = p.out + O_CONV_P + (((size_t)l * 8 + b) * 2 + rr) * 256 + j0;
#pragma unroll
    for (int i = 0; i < 8; i++) dst[i] = a[i] * c[i];
  } else {
    const int i15 = rr - 2;
    float v[8];
    unpack8(*(const uint4*)(proj + (size_t)(b * 2048 + 2033 + i15) * DIN + C_DV + j0), v);
    float* dst = p.out + O_POOL_P + (((size_t)l * 8 + b) * 15 + i15) * 256 + j0;
#pragma unroll
    for (int i = 0; i < 8; i++) dst[i] = v[i];
  }
}

DEVI void kvstate_item(const Params& p, int l, int item) {
  const u16* proj = (const u16*)(p.ws + WS_PROJ);
  const int e = item * 256 + tidx();
  if (e < 65536) {
    const int c4 = e & 31, i = (e >> 5) & 127, b = (e >> 12) & 7, which = e >> 15;
    const uint2 u = *(const uint2*)(proj + (size_t)(b * 2048 + 1920 + i) * DIN + C_AK + which * 128 + c4 * 4);
    float* dst = p.out + (which ? O_SWAV_P : O_SWAK_P) + (((size_t)l * 8 + b) * 128 + i) * 128 + c4 * 4;
    *(float4*)dst = make_float4(blo(u.x), bhi(u.x), blo(u.y), bhi(u.y));
  } else {
    const int e2 = e - 65536;
    const int c4 = e2 & 31, t = (e2 >> 5) & 3, sb = (e2 >> 7) & 127, which = e2 >> 14;
    const uint2 u = *(const uint2*)(proj + (size_t)(T_P + sb * 4 + t) * DIN + C_AK + which * 128 + c4 * 4);
    float* dst = p.out + (which ? O_SWAV_S : O_SWAK_S) + (((size_t)l * 128 + sb) * 128 + 124 + t) * 128 + c4 * 4;
    *(float4*)dst = make_float4(blo(u.x), bhi(u.x), blo(u.y), bhi(u.y));
  }
}


#define XB_TMO      128
#define XB_XCNT(j)  (256  + 64 * (j))
#define XB_XSUB(j)  (1280 + 64 * (j))
#define XB_XGEN(j)  (2304 + 64 * (j))
#define XB_TOP      3328
#define XB_TOPGEN   3392
#define XCD_BAR_WORDS 3456
#define XB_SPIN_CAP (1u << 22)
DEVI unsigned xb_ld(unsigned* p) { return __hip_atomic_load(p, __ATOMIC_RELAXED, __HIP_MEMORY_SCOPE_AGENT); }
DEVI unsigned xb_add(unsigned* p, unsigned v) { return __hip_atomic_fetch_add(p, v, __ATOMIC_RELAXED, __HIP_MEMORY_SCOPE_AGENT); }
DEVI unsigned xb_xcc_id() { return (unsigned)__builtin_amdgcn_s_getreg((3 << 11) | 20) & 0xFu; }
#define XB_SPIN(cond, bar) do { unsigned _sp = 0; while (cond) { __builtin_amdgcn_s_sleep(1); \
    if ((++_sp & 255u) == 0u) { if (xb_ld(&(bar)[XB_TMO])) break; if (_sp > XB_SPIN_CAP) { atomicAdd(&(bar)[XB_TMO], 1u); break; } } } } while (0)
struct XcdBarrier { unsigned* bar; unsigned x; volatile LAS unsigned* st; };
DEVI XcdBarrier xcd_barrier_post(unsigned* bar, volatile LAS unsigned* st) {
  XcdBarrier b; b.bar = bar; b.x = xb_xcc_id(); b.st = st;
  if (threadIdx.x == 0) (void)xb_add(&bar[XB_XCNT(b.x)], 1u);
  return b;
}
DEVI void xcd_barrier_complete(unsigned* bar, unsigned x, unsigned& nloc, unsigned& nx) {
  const unsigned G = gridDim.x * gridDim.y * gridDim.z;
  unsigned sum, cnt, mine, sp = 0u;
  for (;;) {
    sum = 0u; cnt = 0u; mine = 0u;
#pragma unroll
    for (unsigned j = 0; j < 16; ++j) { const unsigned c = xb_ld(&bar[XB_XCNT(j)]); sum += c; cnt += (c > 0u) ? 1u : 0u; mine = (j == x) ? c : mine; }
    if (sum == G) break;
    __builtin_amdgcn_s_sleep(1);
    if ((++sp & 255u) == 0u) { if (xb_ld(&bar[XB_TMO])) break; if (sp > XB_SPIN_CAP) { atomicAdd(&bar[XB_TMO], 1u); break; } }
  }
  nloc = mine > 0u ? mine : 1u; nx = cnt > 0u ? cnt : 1u;
}
DEVI void xcd_barrier(const XcdBarrier& b) {
  asm volatile("s_waitcnt vmcnt(0)" ::: "memory");
  __syncthreads();
  if (threadIdx.x == 0) {
    unsigned* bar = b.bar;
    __builtin_amdgcn_s_waitcnt(0);
    unsigned nloc = b.st[0], nx = b.st[1];
    if (nloc == 0u) { xcd_barrier_complete(bar, b.x, nloc, nx); b.st[0] = nloc; b.st[1] = nx; }
    const unsigned old = xb_add(&bar[XB_XSUB(b.x)], 1u);
    const unsigned gen = old / nloc;
    if (old + 1u == (gen + 1u) * nloc) {
      __builtin_amdgcn_fence(__ATOMIC_RELEASE, "agent");
      asm volatile("s_waitcnt vmcnt(0)" ::: "memory");
      const unsigned og = xb_add(&bar[XB_TOP], 1u);
      const unsigned tg = og / nx;
      if (og + 1u == (tg + 1u) * nx) xb_add(&bar[XB_TOPGEN], 1u);
      else XB_SPIN(xb_ld(&bar[XB_TOPGEN]) == tg, bar);
      __builtin_amdgcn_fence(__ATOMIC_ACQUIRE, "agent");
      xb_add(&bar[XB_XGEN(b.x)], 1u);
      asm volatile("s_waitcnt vmcnt(0)" ::: "memory");
    } else {
      XB_SPIN(xb_ld(&bar[XB_XGEN(b.x)]) == gen, bar);
      __builtin_amdgcn_fence(__ATOMIC_ACQUIRE, "agent");
      asm volatile("s_waitcnt vmcnt(0)" ::: "memory");
    }
  }
  __syncthreads();
}

DEVI int xcd_first_tile() { return (blockIdx.x & 7) * (gridDim.x >> 3) + (blockIdx.x >> 3); }
DEVI int xcd_tile_step() { return gridDim.x; }
DEVI void tile_coords(int T, int MT, int NT, int& mt, int& nt) {
  const int full = MT >> 3, band = T / (8 * NT);
  if (band < full) { const int r = T - band * 8 * NT; nt = r >> 3; mt = band * 8 + (r & 7); }
  else { const int MB = MT - full * 8; const int r = T - full * 8 * NT; nt = r / MB; mt = full * 8 + r % MB; }
}

constexpr int NPHASE = 1 + 4 * 13;

DEVI void run_phase(const Params& p, int ph, char* smem) {
  if (ph == 0) { prologue_phase(p, smem); return; }
  const int l = (ph - 1) / 13, s = (ph - 1) % 13;
  u16* xb = (u16*)(p.ws + WS_XB);
  u16* proj = (u16*)(p.ws + WS_PROJ);
  u16* mix = (u16*)(p.ws + WS_MIX);
  u16* qx = (u16*)(p.ws + WS_QX);
  u16* ox = (u16*)(p.ws + WS_OX);
  u16* hb = (u16*)(p.ws + WS_H);
  const int G = gridDim.x;
  switch (s) {
    case 0: {
      const u16* Bt = (const u16*)(p.ws + WS_WIN) + (size_t)l * 2560 * 1024;
      const int n1 = 66 * 20;
      const int n2 = (l == 0) ? 16 * 16 : 0;
      for (int t = xcd_first_tile(); t < n1 + n2; t += xcd_tile_step()) {
        if (t < n1) { int mt_, nt_; tile_coords(t, 66, 20, mt_, nt_); gemm_tile256<EPI_BF16>(p, xb, 1024, Bt, 1024, mt_ * 256, nt_ * 128, proj, DIN, smem); }
        else {
          const int t2 = t - n1;
          gemm_tile<EPI_MEMKV>(p, (const u16*)(p.ws + WS_MEMP), 1024, (const u16*)(p.ws + WS_WKV), 1024, (t2 % 16) * 128, (t2 / 16) * 128, l, nullptr, 0, smem);
        }
      }
    } break;
    case 1: {
      const int N1 = 1024, N2 = 512, N3 = 256, N4 = 256, N5 = 1024 + 128, N6 = 384 + 17;
      const int tot = N1 + N2 + N3 + N4 + N5 + N6;
      for (int it = blockIdx.x; it < tot; it += G) {
        int i = it;
        if (i < N1) {
          const int b = i >> 7, c = (i >> 2) & 31, h = i & 3;
          const size_t o = ((size_t)(b * 32 + c) * 4 + h);
          hgrn_mfma_item<false>(p, l, b * 2048 + c * 64, h, nullptr, (float*)(p.ws + WS_HU) + o * 4096, (float*)(p.ws + WS_HD) + o * 64, smem);
        } else if ((i -= N1) < N2) {
          const int sb = i >> 2, h = i & 3;
          const size_t o = (((size_t)l * 128 + sb) * 4 + h) * 4096;
          hgrn_item<true, false>(p, l, T_P + sb * 4, 4, h, p.state_hgrn + o, p.out + O_HGRN_S + o, nullptr, smem);
        } else if ((i -= N2) < N3) {
          const int b = i >> 5, qb = (i >> 1) & 15, kv = i & 1;
          const int R0 = b * 2048 + qb * 128;
          const u16* Kb = proj + (ptrdiff_t)(R0 - 128) * DIN + C_AK + kv * 64;
          const u16* Vb = proj + (ptrdiff_t)(R0 - 128) * DIN + C_AV + kv * 64;
          const float s0 = exp2f(-2.f * (float)(kv * 2 + 1)), s1 = exp2f(-2.f * (float)(kv * 2 + 2));
          attn256_item(Kb, DIN, Vb, qb == 0 ? 128 : 0, proj + (size_t)R0 * DIN + kv * 128, DIN, mix + (size_t)R0 * 1024 + kv * 128, 1024, 1,
                       s0, s1, p.attn_sink[l * 4 + kv * 2], p.attn_sink[l * 4 + kv * 2 + 1], smem);
        } else if ((i -= N3) < N4) {
          attn_small_item<1>(p, l, i >> 1, i & 1, smem);
        } else if ((i -= N4) < N5) {
          if (i < 1024) convpool_fast(p, l, i * 16); else convpool_sample(p, l, i - 1024);
        } else {
          i -= N5;
          if (i < 384) kvstate_item(p, l, i); else prompt_state_item(p, l, i - 384);
        }
      }
    } break;
    case 2: {
      {
        const float* hU = (const float*)(p.ws + WS_HU);
        const float* hD = (const float*)(p.ws + WS_HD);
        float* hS = (float*)(p.ws + WS_HS);
        for (int e = blockIdx.x * 256 + tidx(); e < 8 * 4 * 4096; e += G * 256) {
          const int b = e >> 14, h = (e >> 12) & 3, kv = e & 4095, k = kv >> 6;
          float S = 0.f;
#pragma unroll
          for (int c = 0; c < 32; c++) {
            const size_t o = (size_t)(b * 32 + c) * 4 + h;
            hS[o * 4096 + kv] = S;
            S = hD[o * 64 + k] * S + hU[o * 4096 + kv];
          }
          p.out[O_HGRN_P + (((size_t)l * 8 + b) * 4 + h) * 4096 + kv] = S;
        }
      }
      const u16* Bt = (const u16*)(p.ws + WS_POOLT) + (size_t)l * 65536;
      for (int t = xcd_first_tile(); t < 132 * 2; t += xcd_tile_step()) {
        int mt_, nt_; tile_coords(t, 132, 2, mt_, nt_);
        gemm_tile<EPI_POOL>(p, (const u16*)(p.ws + WS_POOLED), 256, Bt, 256, mt_ * 128, nt_ * 128, l, nullptr, 0, smem);
      }
    } break;
    case 3: {
      for (int i = blockIdx.x; i < 1024; i += G) {
        const int b = i >> 7, c = (i >> 2) & 31, h = i & 3;
        const size_t o = ((size_t)(b * 32 + c) * 4 + h);
        hgrn_mfma_item<true>(p, l, b * 2048 + c * 64, h, (const float*)(p.ws + WS_HS) + o * 4096, nullptr, nullptr, smem);
      }
    } break;
    case 4: {
      const u16* Bt = (const u16*)(p.ws + WS_WO) + (size_t)l * 1024 * 1024;
      for (int t = xcd_first_tile(); t < 512 + 16 * 8; t += xcd_tile_step()) {
        if (t < 512) {
          int mt_, nt_; tile_coords(t, 64, 8, mt_, nt_);
          gemm_tile256<EPI_RESID>(p, mix, 1024, Bt, 1024, mt_ * 256, nt_ * 128, nullptr, 0, smem);
        } else {
          const int u_ = t - 512, tl_ = u_ / 8, q_ = u_ - tl_ * 8;
          gemm_tile256<EPI_RESID_ATOMIC>(p, mix, 1024, Bt, 1024, (64 + (tl_ & 1)) * 256, (tl_ >> 1) * 128, nullptr, 0, smem, q_ * 128, 4, q_);
        }
      }
    } break;
    case 5: ln_phase(p, 1, p.ln1_g + l * 1024, p.ln1_b + l * 1024, 8); break;
    case 6: {
      const u16* Bt = (const u16*)(p.ws + WS_WXQ) + (size_t)l * 256 * 1024;
      for (int t = xcd_first_tile(); t < 132 * 2; t += xcd_tile_step()) {
        int mt_, nt_; tile_coords(t, 132, 2, mt_, nt_);
        gemm_tile<EPI_BF16>(p, xb, 1024, Bt, 1024, mt_ * 128, nt_ * 128, l, qx, 256, smem);
      }
    } break;
    case 7: {
      const u16* mkv = (const u16*)(p.ws + WS_MEMKV);
      for (int it = blockIdx.x; it < 512 + 512; it += G) {
        if (it < 512) {
          const int hf = it & 1, i2 = it >> 1;
          const int b = i2 >> 5, h = (i2 >> 3) & 3, tb = i2 & 7;
          const u16* Kb = mkv + ((size_t)(0 * 4 + l) * 2048 + b * 256) * 256 + h * 64;
          const u16* Vb = mkv + ((size_t)(4 + l) * 2048 + b * 256) * 256 + h * 64;
          const size_t qo = (size_t)(b * 2048 + tb * 256) * 256 + h * 64;
          attn256_item(Kb, 256, Vb, 0, qx + qo, 256, ox + qo, 256, 0, 0.f, 0.f, 0.f, 0.f, smem, hf * 2, hf * 2 + 2);
        } else {
          const int i = it - 512;
          attn_small_item<0>(p, l, i >> 2, i & 3, smem);
        }
      }
    } break;
    case 8: {
      const u16* Bt = (const u16*)(p.ws + WS_WXO) + (size_t)l * 1024 * 256;
      for (int t = xcd_first_tile(); t < 512 + 16 * 2; t += xcd_tile_step()) {
        if (t < 512) {
          int mt_, nt_; tile_coords(t, 64, 8, mt_, nt_);
          gemm_tile256<EPI_RESID>(p, ox, 256, Bt, 256, mt_ * 256, nt_ * 128, nullptr, 0, smem);
        } else {
          const int u_ = t - 512, tl_ = u_ / 2, q_ = u_ - tl_ * 2;
          gemm_tile256<EPI_RESID_ATOMIC>(p, ox, 256, Bt, 256, (64 + (tl_ & 1)) * 256, (tl_ >> 1) * 128, nullptr, 0, smem, q_ * 128, 4, q_);
        }
      }
    } break;
    case 9: ln_phase(p, 1, p.ln2_g + l * 1024, p.ln2_b + l * 1024, 2); break;
    case 10: {
      const u16* Bt = (const u16*)(p.ws + WS_WGU) + (size_t)l * 5632 * 1024;
      for (int t = xcd_first_tile(); t < 66 * 44; t += xcd_tile_step()) {
        int mt_, nt_; tile_coords(t, 66, 44, mt_, nt_);
        gemm_tile256<EPI_SWIGLU>(p, xb, 1024, Bt, 1024, mt_ * 256, nt_ * 128, hb, DFF, smem);
      }
    } break;
    case 11: {
      const u16* Bt = (const u16*)(p.ws + WS_WDN) + (size_t)l * 1024 * 2816;
      for (int t = xcd_first_tile(); t < 512 + 16 * 11; t += xcd_tile_step()) {
        if (t < 512) {
          int mt_, nt_; tile_coords(t, 64, 8, mt_, nt_);
          gemm_tile256<EPI_RESID>(p, hb, DFF, Bt, DFF, mt_ * 256, nt_ * 128, nullptr, 0, smem);
        } else {
          const int u_ = t - 512, tl_ = u_ / 11, q_ = u_ - tl_ * 11;
          gemm_tile256<EPI_RESID_ATOMIC>(p, hb, DFF, Bt, DFF, (64 + (tl_ & 1)) * 256, (tl_ >> 1) * 128, nullptr, 0, smem, q_ * 256, 8, q_);
        }
      }
    } break;
    case 12: ln_phase(p, l == 3 ? 2 : 1, p.ln3_g + l * 1024, p.ln3_b + l * 1024, 11); break;
  }
}

#if MEGA
__global__ void __launch_bounds__(256, 2) mega_kernel(Params p) {
  __shared__ __attribute__((aligned(16))) char smem[SMEM_BYTES];
  __shared__ uint4 xb_words;
  cg::grid_group grid = cg::this_grid();
  if (threadIdx.x == 0) xb_words = make_uint4(0u, 0u, 0u, 0u);
  __syncthreads();
  XcdBarrier xb = xcd_barrier_post((unsigned*)(p.ws + WS_BAR), (volatile LAS unsigned*)&xb_words);
  for (int ph = 0; ph < NPHASE; ph++) {
    run_phase(p, ph, smem);
#ifdef REPEAT_MASK
    if (ph > 0 && ((REPEAT_MASK >> ((ph - 1) % 13)) & 1)) run_phase(p, ph, smem);
    if (ph == 0 && (REPEAT_MASK & 0x10000)) run_phase(p, ph, smem);
#endif
    if (p.ws == nullptr) grid.sync();
    if (ph + 1 < NPHASE) xcd_barrier(xb);
  }
}

#else
__global__ void __launch_bounds__(256, 2) phase_kernel(Params p, int ph) {
  __shared__ __attribute__((aligned(16))) char smem[SMEM_BYTES];
  run_phase(p, ph, smem);
}
#endif

extern "C" void kernel_launch(void* const* d_in, const int* in_sizes, int n_in, void* d_out, int out_size, void* d_ws, size_t ws_size,
                              hipStream_t stream) {
  if (n_in < 33 || (size_t)out_size != O_TOTAL || ws_size < WS_TOTAL) {
    fprintf(stderr, "kernel_launch: unexpected sizes n_in=%d out=%d ws=%zu need=%zu\n", n_in, out_size, ws_size, (size_t)WS_TOTAL);
    return;
  }
  Params p{};
  const float** pp = (const float**)&p;
  for (int i = 0; i < 33; i++) pp[i] = (const float*)d_in[i];
  p.out = (float*)d_out;
  p.ws = (char*)d_ws;
#if MEGA
  static int grid_blocks = 0;
  if (!grid_blocks) {
    int dev = 0, cus = 0, per_cu = 0;
    (void)hipGetDevice(&dev);
    (void)hipDeviceGetAttribute(&cus, hipDeviceAttributeMultiprocessorCount, dev);
    (void)hipOccupancyMaxActiveBlocksPerMultiprocessor(&per_cu, mega_kernel, 256, 0);
    if (per_cu > 2) per_cu = 2;
    grid_blocks = cus * per_cu;
  }
  (void)hipMemsetAsync((char*)d_ws + WS_BAR, 0, 16384, stream);
  void* args[] = {&p};
  hipError_t e = hipLaunchCooperativeKernel((void*)mega_kernel, dim3(grid_blocks), dim3(256), args, 0, stream);
  if (e != hipSuccess) fprintf(stderr, "cooperative launch failed: %s (grid %d)\n", hipGetErrorString(e), grid_blocks);
#else
  for (int ph = 0; ph < NPHASE; ph++) phase_kernel<<<512, 256, 0, stream>>>(p, ph);
#endif
}
```
